# Optimizing an MI355X kernel written in HIP

```python
import math
import jax
import jax.numpy as jnp
from jax import lax
import numpy as np

D_MODEL = 1024
BATCH = 32
SEQ = 2048
DEPTH = 2

GRID_W = 64
CTX_LEN = 256
HEAD_DIM = 64
N_MIXERS = 4
GROUP_WIDTH = D_MODEL // N_MIXERS

SWA_HEADS = GROUP_WIDTH // HEAD_DIM
SWA_KV_HEADS = 2
SWA_GQA = SWA_HEADS // SWA_KV_HEADS
SWA_WINDOW = 128
SWA_BLOCK = 128
ROPE_BASE = 10000.0

NA_HEADS = GROUP_WIDTH // HEAD_DIM
NA_ROWS = 8
NA_COLS = 16
NA_QB = 16
NA_KB = NA_QB + NA_COLS

HGRN_HEADS = GROUP_WIDTH // HEAD_DIM
HGRN_DK = HEAD_DIM
HGRN_DV = HEAD_DIM
HGRN_CHUNK = 64

S5_GROUP_CH = 16
S5_GROUPS = GROUP_WIDTH // S5_GROUP_CH
S5_STATE = 64

MOE_GROUPS = 4
MOE_PER_GROUP = 8
MOE_EXPERTS = MOE_GROUPS * MOE_PER_GROUP
MOE_TOPK = 2
MOE_HIDDEN = 512

NORM_EPS = 1e-6
NEG_INF = -1e30

PROJ_SIZES = (GROUP_WIDTH, SWA_KV_HEADS * HEAD_DIM, SWA_KV_HEADS * HEAD_DIM,
              GROUP_WIDTH, GROUP_WIDTH, GROUP_WIDTH,
              GROUP_WIDTH, GROUP_WIDTH, GROUP_WIDTH, GROUP_WIDTH, GROUP_WIDTH,
              GROUP_WIDTH)
PROJ_WIDTH = sum(PROJ_SIZES)

kernel_name = 'hybrid_dit_parallel_groups_hmoe'


def _rmsnorm(x, w):
    xf = x.astype(jnp.float32)
    y = xf * lax.rsqrt(jnp.mean(xf * xf, axis=-1, keepdims=True) + NORM_EPS)
    return (y * w.astype(jnp.float32)).astype(x.dtype)


def _modulate(h, shift, scale):
    return h * (1 + scale) + shift


def _rotate(x, ang):
    n = x.shape[-1] // 2
    cos = jnp.cos(ang)[None, :, None, :].astype(x.dtype)
    sin = jnp.sin(ang)[None, :, None, :].astype(x.dtype)
    x1, x2 = x[..., :n], x[..., n:]
    return jnp.concatenate([x1 * cos - x2 * sin, x1 * sin + x2 * cos], axis=-1)


def _rope_2d(x, row, col):
    half = HEAD_DIM // 2
    inv = 1.0 / (ROPE_BASE ** (jnp.arange(0, half, 2, dtype=jnp.float32) / half))
    ang_r = row.astype(jnp.float32)[:, None] * inv[None, :]
    ang_c = col.astype(jnp.float32)[:, None] * inv[None, :]
    return jnp.concatenate([_rotate(x[..., :half], ang_r), _rotate(x[..., half:], ang_c)], axis=-1)


def _sink_softmax(s, sink):
    m = jnp.maximum(jnp.max(s, axis=-1, keepdims=True), sink)
    e = jnp.exp(s - m)
    return e / (jnp.sum(e, axis=-1, keepdims=True) + jnp.exp(sink - m))


def _swa_mixer(q, k, v, qc, kc, vc, sink, row, col, need_ctx):
    bsz, n = q.shape[0], q.shape[1]
    scale = HEAD_DIM ** -0.5
    qg = (_rope_2d(q, row, col) * scale).reshape(bsz, n, SWA_KV_HEADS, SWA_GQA, HEAD_DIM)
    pad = ((0, 0), (SWA_WINDOW, SWA_WINDOW), (0, 0), (0, 0))
    kp = jnp.pad(_rope_2d(k, row, col), pad)
    vp = jnp.pad(v, pad)
    sink_b = sink.astype(jnp.float32).reshape(SWA_KV_HEADS, SWA_GQA, 1, 1)
    span = SWA_BLOCK + 2 * SWA_WINDOW

    def block(i):
        start = i * SWA_BLOCK
        qb = lax.dynamic_slice_in_dim(qg, start, SWA_BLOCK, axis=1)
        kb = lax.dynamic_slice_in_dim(kp, start, span, axis=1)
        vb = lax.dynamic_slice_in_dim(vp, start, span, axis=1)
        qpos = start + jnp.arange(SWA_BLOCK)
        kpos = start - SWA_WINDOW + jnp.arange(span)
        valid = ((jnp.abs(qpos[:, None] - kpos[None, :]) <= SWA_WINDOW)
                 & (kpos >= 0)[None, :] & (kpos < n)[None, :])
        s_lat = jnp.einsum('bqkgd,bskd->bkgqs', qb, kb).astype(jnp.float32)
        s_lat = jnp.where(valid, s_lat, NEG_INF)
        s_ctx = jnp.einsum('bqkgd,bskd->bkgqs', qb, kc).astype(jnp.float32)
        p = _sink_softmax(jnp.concatenate([s_lat, s_ctx], axis=-1), sink_b).astype(v.dtype)
        o = (jnp.einsum('bkgqs,bskd->bqkgd', p[..., :span], vb)
             + jnp.einsum('bkgqs,bskd->bqkgd', p[..., span:], vc))
        return o.reshape(bsz, SWA_BLOCK, SWA_HEADS * HEAD_DIM)

    out = lax.map(block, jnp.arange(n // SWA_BLOCK))
    out = jnp.moveaxis(out, 0, 1).reshape(bsz, n, SWA_HEADS * HEAD_DIM)
    out_c = None
    if need_ctx:
        lc = qc.shape[1]
        qcg = (qc * scale).reshape(bsz, lc, SWA_KV_HEADS, SWA_GQA, HEAD_DIM)
        s = jnp.einsum('bqkgd,bskd->bkgqs', qcg, kc).astype(jnp.float32)
        p = _sink_softmax(s, sink_b).astype(v.dtype)
        out_c = jnp.einsum('bkgqs,bskd->bqkgd', p, vc).reshape(bsz, lc, SWA_HEADS * HEAD_DIM)
    return out, out_c


def _na_mixer(q, k, v, qc, kc, vc, rpb, rows, need_ctx):
    bsz, n = q.shape[0], q.shape[1]
    wr = min(NA_ROWS, rows)
    ncb = GRID_W // NA_QB
    scale = HEAD_DIM ** -0.5
    qgrid = (q * scale).reshape(bsz, rows, GRID_W, NA_HEADS, HEAD_DIM)
    kgrid = k.reshape(bsz, rows, GRID_W, NA_HEADS, HEAD_DIM)
    vgrid = v.reshape(bsz, rows, GRID_W, NA_HEADS, HEAD_DIM)
    row_start = jnp.clip(jnp.arange(rows) - wr // 2, 0, rows - wr)
    qcols = np.arange(GRID_W).reshape(ncb, NA_QB)
    win_start = np.clip(qcols - NA_COLS // 2, 0, GRID_W - NA_COLS)
    kcols = (np.clip(np.arange(ncb) * NA_QB - NA_COLS // 2, 0, GRID_W - NA_KB)[:, None]
             + np.arange(NA_KB)[None, :])
    col_valid = ((kcols[:, None, :] >= win_start[:, :, None])
                 & (kcols[:, None, :] < win_start[:, :, None] + NA_COLS))
    col_idx = np.clip(kcols[:, None, :] - qcols[:, :, None] + NA_COLS - 1, 0, 2 * NA_COLS - 2)
    bias = jnp.transpose(rpb.astype(jnp.float32)[:, :, col_idx], (0, 2, 3, 1, 4))
    bias = jnp.where(col_valid[None, :, :, None, :], bias, NEG_INF)
    n_lat = wr * NA_KB

    def row_block(r):
        rs = row_start[r]
        qr = qgrid[:, r].reshape(bsz, ncb, NA_QB, NA_HEADS, HEAD_DIM)
        kb = lax.dynamic_slice_in_dim(kgrid, rs, wr, axis=1)[:, :, kcols]
        vb = lax.dynamic_slice_in_dim(vgrid, rs, wr, axis=1)[:, :, kcols]
        b_r = jnp.take(bias, rs + jnp.arange(wr) - r + NA_ROWS - 1, axis=3)
        s_lat = jnp.einsum('bjqhd,brjkhd->bhjqrk', qr, kb).astype(jnp.float32) + b_r[None]
        s_lat = s_lat.reshape(bsz, NA_HEADS, ncb, NA_QB, n_lat)
        s_ctx = jnp.einsum('bjqhd,bshd->bhjqs', qr, kc).astype(jnp.float32)
        p = jax.nn.softmax(jnp.concatenate([s_lat, s_ctx], axis=-1), axis=-1).astype(v.dtype)
        p_lat = p[..., :n_lat].reshape(bsz, NA_HEADS, ncb, NA_QB, wr, NA_KB)
        o = (jnp.einsum('bhjqrk,brjkhd->bjqhd', p_lat, vb)
             + jnp.einsum('bhjqs,bshd->bjqhd', p[..., n_lat:], vc))
        return o.reshape(bsz, GRID_W, NA_HEADS * HEAD_DIM)

    out = lax.map(row_block, jnp.arange(rows))
    out = jnp.moveaxis(out, 0, 1).reshape(bsz, n, NA_HEADS * HEAD_DIM)
    out_c = None
    if need_ctx:
        lc = qc.shape[1]
        s = jnp.einsum('bqhd,bshd->bhqs', qc * scale, kc).astype(jnp.float32)
        p = jax.nn.softmax(s, axis=-1).astype(v.dtype)
        out_c = jnp.einsum('bhqs,bshd->bqhd', p, vc).reshape(bsz, lc, NA_HEADS * HEAD_DIM)
    return out, out_c


def _hgrn_forget(f_raw, lb):
    f = lb + (1.0 - lb) * jax.nn.sigmoid(f_raw)
    return 1.0 - f, jnp.log(f)


def _gla_chunked(q, k, v, logf, s0):
    bsz, n, nh = q.shape[0], q.shape[1], q.shape[2]
    nc = n // HGRN_CHUNK

    def chunks(t):
        return jnp.transpose(t.reshape(bsz, nc, HGRN_CHUNK, nh, t.shape[-1]), (1, 0, 3, 2, 4))

    causal = jnp.tril(jnp.ones((HGRN_CHUNK, HGRN_CHUNK), dtype=bool))[:, :, None]

    def step(state, blk):
        qb, kb, vb, gb = blk
        b = jnp.cumsum(gb, axis=2)
        b_last = b[:, :, -1:, :]
        diff = jnp.where(causal, b[:, :, :, None, :] - b[:, :, None, :, :], -jnp.inf)
        attn = jnp.einsum('bhtk,bhsk,bhtsk->bhts', qb, kb, jnp.exp(diff))
        o = (jnp.einsum('bhtk,bhkv->bhtv', qb * jnp.exp(b), state)
             + jnp.einsum('bhts,bhsv->bhtv', attn, vb))
        state = (jnp.exp(b_last[:, :, 0, :])[..., None] * state
                 + jnp.einsum('bhsk,bhsv->bhkv', kb * jnp.exp(b_last - b), vb))
        return state, o

    state, o = lax.scan(step, s0, (chunks(q), chunks(k), chunks(v), chunks(logf)))
    o = jnp.transpose(o, (1, 0, 3, 2, 4)).reshape(bsz, n, nh, v.shape[-1])
    return o, state


def _gated_rmsnorm(o, g, w):
    o = o * lax.rsqrt(jnp.mean(o * o, axis=-1, keepdims=True) + NORM_EPS) * w.astype(jnp.float32)
    gate = jax.nn.silu(g.astype(jnp.float32)).reshape(o.shape)
    return (o * gate).reshape(o.shape[0], o.shape[1], -1)


def _flip(t, rev):
    return jnp.flip(t, axis=1) if rev else t


def _hgrn2_mixer(q, f_fw, f_bw, i, g, qc, fc_fw, fc_bw, ic, gc, lb_fw, lb_bw, norm_w, need_ctx):
    def heads(t):
        return t.astype(jnp.float32).reshape(t.shape[0], t.shape[1], HGRN_HEADS, -1)

    qh, vh = heads(jax.nn.silu(q)), heads(i)
    qch, vch = heads(jax.nn.silu(qc)), heads(ic)
    s0 = jnp.zeros((q.shape[0], HGRN_HEADS, HGRN_DK, HGRN_DV), jnp.float32)
    o = jnp.zeros_like(vh)
    oc = jnp.zeros_like(vch) if need_ctx else None
    for rev, f_raw, fc_raw, lb in ((False, f_fw, fc_fw, lb_fw), (True, f_bw, fc_bw, lb_bw)):
        lbh = lb.reshape(HGRN_HEADS, HGRN_DK)
        kh, logf = _hgrn_forget(heads(f_raw), lbh)
        kch, logfc = _hgrn_forget(heads(fc_raw), lbh)
        o_ctx, s_ctx = _gla_chunked(_flip(qch, rev), _flip(kch, rev), _flip(vch, rev), _flip(logfc, rev), s0)
        o_lat, _ = _gla_chunked(_flip(qh, rev), _flip(kh, rev), _flip(vh, rev), _flip(logf, rev), s_ctx)
        o = o + _flip(o_lat, rev)
        if need_ctx:
            oc = oc + _flip(o_ctx, rev)
    out = _gated_rmsnorm(o, g, norm_w).astype(q.dtype)
    out_c = _gated_rmsnorm(oc, gc, norm_w).astype(q.dtype) if need_ctx else None
    return out, out_c


def _s5_discretize(lam_re, lam_im, log_dt, b_re, b_im):
    dt = jnp.exp(log_dt)[:, None]
    mag = jnp.exp(lam_re * dt)
    a_re, a_im = mag * jnp.cos(lam_im * dt), mag * jnp.sin(lam_im * dt)
    den = lam_re * lam_re + lam_im * lam_im
    k_re = ((a_re - 1.0) * lam_re + a_im * lam_im) / den
    k_im = (a_im * lam_re - (a_re - 1.0) * lam_im) / den
    bb_re = k_re[..., None] * b_re - k_im[..., None] * b_im
    bb_im = k_re[..., None] * b_im + k_im[..., None] * b_re
    return a_re, a_im, bb_re, bb_im


def _s5_scan(u, a_re, a_im, bb_re, bb_im, h0=None):
    n = u.shape[1]
    x_re = jnp.einsum('blgh,gph->blgp', u, bb_re)
    x_im = jnp.einsum('blgh,gph->blgp', u, bb_im)
    if h0 is not None:
        h_re, h_im = h0
        x_re = x_re.at[:, 0].add(a_re * h_re - a_im * h_im)
        x_im = x_im.at[:, 0].add(a_re * h_im + a_im * h_re)
    shape = (1, n) + a_re.shape

    def combine(e1, e2):
        a1r, a1i, b1r, b1i = e1
        a2r, a2i, b2r, b2i = e2
        return (a2r * a1r - a2i * a1i, a2r * a1i + a2i * a1r,
                a2r * b1r - a2i * b1i + b2r, a2r * b1i + a2i * b1r + b2i)

    _, _, x_re, x_im = lax.associative_scan(
        combine, (jnp.broadcast_to(a_re, shape), jnp.broadcast_to(a_im, shape), x_re, x_im), axis=1)
    return x_re, x_im


def _s5_readout(x_re, x_im, c_re, c_im):
    y = jnp.einsum('blgp,ghp->blgh', x_re, c_re) - jnp.einsum('blgp,ghp->blgh', x_im, c_im)
    return y.reshape(y.shape[0], y.shape[1], -1)


def _s5_glu(y, w, b):
    z = jax.nn.gelu(y)
    return z * jax.nn.sigmoid(z @ w.astype(jnp.float32) + b.astype(jnp.float32))


def _s5_mixer(u, uc, lam_re, lam_im, log_dt, b_re, b_im, c_re, c_im, d, glu_w, glu_b, need_ctx):
    f32 = jnp.float32

    def groups(t):
        return t.astype(f32).reshape(t.shape[0], t.shape[1], S5_GROUPS, S5_GROUP_CH)

    ug, ucg = groups(u), groups(uc)
    y = d.astype(f32) * u.astype(f32)
    yc = d.astype(f32) * uc.astype(f32) if need_ctx else None
    for direc in range(2):
        rev = direc == 1
        a_re, a_im, bb_re, bb_im = _s5_discretize(
            lam_re[direc].astype(f32), lam_im[direc].astype(f32), log_dt[direc].astype(f32),
            b_re[direc].astype(f32), b_im[direc].astype(f32))
        cr, ci = c_re[direc].astype(f32), c_im[direc].astype(f32)
        xc_re, xc_im = _s5_scan(_flip(ucg, rev), a_re, a_im, bb_re, bb_im)
        x_re, x_im = _s5_scan(_flip(ug, rev), a_re, a_im, bb_re, bb_im, (xc_re[:, -1], xc_im[:, -1]))
        y = y + _flip(_s5_readout(x_re, x_im, cr, ci), rev)
        if need_ctx:
            yc = yc + _flip(_s5_readout(xc_re, xc_im, cr, ci), rev)
    out = _s5_glu(y, glu_w, glu_b).astype(u.dtype)
    out_c = _s5_glu(yc, glu_w, glu_b).astype(u.dtype) if need_ctx else None
    return out, out_c


def _token_mixers(h, hc, w_in, sink, rpb, lb_fw, lb_bw, hg_norm_w, s5_params, row, col, rows, need_ctx):
    cuts = [int(v) for v in np.cumsum(PROJ_SIZES)[:-1]]
    p = jnp.split(h @ w_in, cuts, axis=-1)
    pc = jnp.split(hc @ w_in, cuts, axis=-1)

    def hd(t):
        return t.reshape(t.shape[0], t.shape[1], -1, HEAD_DIM)

    a, a_c = _swa_mixer(hd(p[0]), hd(p[1]), hd(p[2]), hd(pc[0]), hd(pc[1]), hd(pc[2]),
                        sink, row, col, need_ctx)
    b, b_c = _na_mixer(hd(p[3]), hd(p[4]), hd(p[5]), hd(pc[3]), hd(pc[4]), hd(pc[5]),
                       rpb, rows, need_ctx)
    cm, c_c = _hgrn2_mixer(p[6], p[7], p[8], p[9], p[10], pc[6], pc[7], pc[8], pc[9], pc[10],
                           lb_fw, lb_bw, hg_norm_w, need_ctx)
    dm, d_c = _s5_mixer(p[11], pc[11], *s5_params, need_ctx)
    mix = jnp.concatenate([a, b, cm, dm], axis=-1)
    mix_c = jnp.concatenate([a_c, b_c, c_c, d_c], axis=-1) if need_ctx else None
    return mix, mix_c


def _hier_moe(t, gw, gb, ew, eb, w_gate, w_up, w_down):
    g_logits = (t @ gw + gb).astype(jnp.float32)
    g_prob = jax.nn.softmax(g_logits, axis=-1)
    g_idx = jnp.argmax(g_logits, axis=-1)
    g_w = jnp.take_along_axis(g_prob, g_idx[:, None], axis=-1)
    e_logits = (t @ ew + eb).astype(jnp.float32).reshape(-1, MOE_GROUPS, MOE_PER_GROUP)
    e_in = jnp.take_along_axis(e_logits, g_idx[:, None, None], axis=1)[:, 0]
    top_v, top_i = lax.top_k(e_in, MOE_TOPK)
    w = jax.nn.softmax(top_v, axis=-1) * g_w
    eid = g_idx[:, None] * MOE_PER_GROUP + top_i
    combine = jnp.sum(jax.nn.one_hot(eid, MOE_EXPERTS, dtype=jnp.float32) * w[..., None], axis=1).astype(t.dtype)
    y = jnp.zeros_like(t)
    for e in range(MOE_EXPERTS):
        hid = jax.nn.silu(t @ w_gate[e]) * (t @ w_up[e])
        y = y + combine[:, e:e + 1] * (hid @ w_down[e])
    return y


def setup_inputs(seed: int = 0) -> dict:
    key = jax.random.key(seed)
    ks = iter(jax.random.split(key, 40))
    f32 = jnp.float32

    def nrm(shape, scale):
        return jax.random.normal(next(ks), shape, f32) * scale

    D = D_MODEL
    G, P, Hs = S5_GROUPS, S5_STATE, S5_GROUP_CH
    lam_im_base = jnp.broadcast_to(math.pi * jnp.arange(P, dtype=f32), (DEPTH, 2, G, P))
    return {
        'x': nrm((BATCH, SEQ, D), 1.0),
        'c': nrm((BATCH, D), 1.0),
        'ctx': nrm((BATCH, CTX_LEN, D), 1.0),
        'c_ctx': nrm((D,), 1.0),
        'mod_w': nrm((DEPTH, D, 6 * D), 0.5 * D ** -0.5),
        'mod_b': nrm((DEPTH, 6 * D), 0.01),
        'norm1_w': 1.0 + nrm((DEPTH, D), 0.01),
        'norm2_w': 1.0 + nrm((DEPTH, D), 0.01),
        'w_in': nrm((DEPTH, D, PROJ_WIDTH), D ** -0.5),
        'w_out': nrm((DEPTH, D, D), D ** -0.5),
        'swa_sink': nrm((DEPTH, SWA_HEADS), 0.5),
        'na_rpb': nrm((DEPTH, NA_HEADS, 2 * NA_ROWS - 1, 2 * NA_COLS - 1), 0.1),
        'hgrn_lb': nrm((2, DEPTH, GROUP_WIDTH), 0.5),
        'hgrn_norm_w': 1.0 + nrm((DEPTH, HGRN_DV), 0.01),
        's5_lam_re': -0.5 + nrm((DEPTH, 2, G, P), 0.01),
        's5_lam_im': lam_im_base + nrm((DEPTH, 2, G, P), 0.01),
        's5_log_dt': jax.random.uniform(next(ks), (DEPTH, 2, G), f32, math.log(1e-3), math.log(1e-1)),
        's5_b_re': nrm((DEPTH, 2, G, P, Hs), (2 * Hs) ** -0.5),
        's5_b_im': nrm((DEPTH, 2, G, P, Hs), (2 * Hs) ** -0.5),
        's5_c_re': nrm((DEPTH, 2, G, Hs, P), P ** -0.5),
        's5_c_im': nrm((DEPTH, 2, G, Hs, P), P ** -0.5),
        's5_d': nrm((DEPTH, GROUP_WIDTH), 1.0),
        's5_glu_w': nrm((DEPTH, GROUP_WIDTH, GROUP_WIDTH), GROUP_WIDTH ** -0.5),
        's5_glu_b': nrm((DEPTH, GROUP_WIDTH), 0.01),
        'moe_group_w': nrm((DEPTH, D, MOE_GROUPS), D ** -0.5),
        'moe_group_b': nrm((DEPTH, MOE_GROUPS), 0.01),
        'moe_expert_w': nrm((DEPTH, D, MOE_EXPERTS), D ** -0.5),
        'moe_expert_b': nrm((DEPTH, MOE_EXPERTS), 0.01),
        'moe_w_gate': nrm((DEPTH, MOE_EXPERTS, D, MOE_HIDDEN), D ** -0.5),
        'moe_w_up': nrm((DEPTH, MOE_EXPERTS, D, MOE_HIDDEN), D ** -0.5),
        'moe_w_down': nrm((DEPTH, MOE_EXPERTS, MOE_HIDDEN, D), MOE_HIDDEN ** -0.5),
        'final_norm_w': 1.0 + nrm((D,), 0.01),
    }


def reference(x, c, ctx, c_ctx, mod_w, mod_b, norm1_w, norm2_w, w_in, w_out,
              swa_sink, na_rpb, hgrn_lb, hgrn_norm_w,
              s5_lam_re, s5_lam_im, s5_log_dt, s5_b_re, s5_b_im, s5_c_re, s5_c_im, s5_d, s5_glu_w, s5_glu_b,
              moe_group_w, moe_group_b, moe_expert_w, moe_expert_b, moe_w_gate, moe_w_up, moe_w_down,
              final_norm_w):
    bsz, n_tok, dm = x.shape
    rows = n_tok // GRID_W
    t = jnp.arange(n_tok)
    row, col = t // GRID_W, t % GRID_W
    lbp = jax.nn.softmax(hgrn_lb.astype(jnp.float32), axis=1)
    lower_bound = jnp.cumsum(lbp, axis=1) - lbp[:, :1]
    c_act = jax.nn.silu(c)
    cc_act = jax.nn.silu(c_ctx)
    n_lat = bsz * n_tok
    for l in range(DEPTH):
        last = l == DEPTH - 1
        mod = jnp.split(c_act @ mod_w[l] + mod_b[l], 6, axis=-1)
        modc = jnp.split(cc_act @ mod_w[l] + mod_b[l], 6, axis=-1)
        h = _modulate(_rmsnorm(x, norm1_w[l]), mod[0][:, None], mod[1][:, None])
        hc = _modulate(_rmsnorm(ctx, norm1_w[l]), modc[0], modc[1])
        s5_params = (s5_lam_re[l], s5_lam_im[l], s5_log_dt[l], s5_b_re[l], s5_b_im[l],
                     s5_c_re[l], s5_c_im[l], s5_d[l], s5_glu_w[l], s5_glu_b[l])
        mix, mix_c = _token_mixers(h, hc, w_in[l], swa_sink[l], na_rpb[l],
                                   lower_bound[0, l], lower_bound[1, l], hgrn_norm_w[l],
                                   s5_params, row, col, rows, not last)
        x = x + mod[2][:, None] * (mix @ w_out[l])
        moe_w = (moe_group_w[l], moe_group_b[l], moe_expert_w[l], moe_expert_b[l],
                 moe_w_gate[l], moe_w_up[l], moe_w_down[l])
        h2 = _modulate(_rmsnorm(x, norm2_w[l]), mod[3][:, None], mod[4][:, None])
        if last:
            x = x + mod[5][:, None] * _hier_moe(h2.reshape(-1, dm), *moe_w).reshape(x.shape)
        else:
            ctx = ctx + modc[2] * (mix_c @ w_out[l])
            h2c = _modulate(_rmsnorm(ctx, norm2_w[l]), modc[3], modc[4])
            y = _hier_moe(jnp.concatenate([h2.reshape(-1, dm), h2c.reshape(-1, dm)], axis=0), *moe_w)
            x = x + mod[5][:, None] * y[:n_lat].reshape(x.shape)
            ctx = ctx + modc[5] * y[n_lat:].reshape(ctx.shape)
    return _rmsnorm(x, final_norm_w)
```

```cpp
#include <hip/hip_runtime.h>
#include <stdint.h>
#include <stdio.h>

#ifndef N_LAUNCH_MODE
#define N_LAUNCH_MODE 1
#endif

#define LAS __attribute__((address_space(3)))
typedef unsigned short bf16_t;
typedef short bf16x8 __attribute__((ext_vector_type(8)));
typedef float f32x4 __attribute__((ext_vector_type(4)));
typedef float f32x2 __attribute__((ext_vector_type(2)));
typedef unsigned u32x4 __attribute__((ext_vector_type(4)));
typedef unsigned u32x2 __attribute__((ext_vector_type(2)));

constexpr int DM = 1024, NBATCH = 32, SEQL = 2048, CTXL = 256;
constexpr int TLAT = NBATCH * SEQL, TCTX = NBATCH * CTXL, TALL = TLAT + TCTX;
constexpr int PW = 2816;
constexpr int C_AQ = 0, C_AK = 256, C_AV = 384, C_BQ = 512, C_BK = 768, C_BV = 1024, C_CQ = 1280, C_CFF = 1536, C_CFB = 1792, C_CI = 2048, C_CG = 2304, C_DU = 2560;
constexpr int NEXP = 32, MHID = 512;
constexpr int SLOTCAP = TALL + NEXP * 256;
constexpr int NWG = 256, NTHR = 512;
constexpr int LDS_BYTES = 153600;
constexpr float NORM_EPS = 1e-6f;

constexpr size_t MB = 1024ull * 1024ull;
constexpr size_t WS_BAR = 0;
constexpr size_t WS_NTILES = 32 * 1024;
constexpr size_t WS_TILEE = 36 * 1024;
constexpr size_t WS_HIST = 64 * 1024;
constexpr size_t WS_MODV = 256 * 1024;
constexpr size_t WS_TOKE = 2 * MB;
constexpr size_t WS_TOKW = 2 * MB + 640 * 1024;
constexpr size_t WS_SLOTTOK = 3 * MB + 512 * 1024;
constexpr size_t WS_SLOTW = 4 * MB + 256 * 1024;
constexpr size_t WS_GLUT = 5 * MB;
constexpr size_t WS_WINT = 6 * MB;
constexpr size_t WS_WOUTT = 17 * MB;
constexpr size_t WS_X = 21 * MB;
constexpr size_t WS_H = 309 * MB;
constexpr size_t WS_P = 453 * MB;
constexpr size_t WS_MIX = 849 * MB;
constexpr size_t WS_SSQ = 993 * MB;
constexpr size_t WS_END = 998 * MB;
constexpr size_t WS_W1T = WS_P;
constexpr size_t WS_W2T = WS_P + 64 * MB;
constexpr size_t WS_HID = WS_P + 96 * MB;
constexpr size_t SPART = (size_t)TALL * 256;

__device__ __forceinline__ float bf2f(bf16_t v) { return __uint_as_float(((unsigned)v) << 16); }
typedef __bf16 bf16x2_t __attribute__((ext_vector_type(2)));
__device__ __forceinline__ unsigned cvt_pk_bf16(float lo, float hi) { const f32x2 v = {lo, hi}; const bf16x2_t r = __builtin_convertvector(v, bf16x2_t); return __builtin_bit_cast(unsigned, r); }
__device__ __forceinline__ bf16_t f2bf(float f) { return (bf16_t)(cvt_pk_bf16(f, 0.f) & 0xffffu); }
__device__ __forceinline__ float lo_bf(unsigned w) { return __uint_as_float(w << 16); }
__device__ __forceinline__ float hi_bf(unsigned w) { return __uint_as_float(w & 0xffff0000u); }
__device__ __forceinline__ float wave_sum(float v) { for (int o = 32; o >= 1; o >>= 1) v += __shfl_xor(v, o); return v; }
__device__ __forceinline__ float sigmoidf_(float x) { return 1.0f / (1.0f + __expf(-x)); }
__device__ __forceinline__ float siluf_(float x) { return x / (1.0f + __expf(-x)); }
__device__ __forceinline__ float gelu_tanh(float y) { const float u = 0.7978845608028654f * (y + 0.044715f * y * y * y); const float e = __expf(2.0f * u); const float th = 1.0f - 2.0f / (e + 1.0f); return 0.5f * y * (1.0f + th); }
__device__ __forceinline__ int mod_row(int row) { return row < TLAT ? (row >> 11) : 32; }

#define XB_TMO      128
#define XB_XCNT(j)  (256  + 64 * (j))
#define XB_XSUB(j)  (1280 + 64 * (j))
#define XB_XGEN(j)  (2304 + 64 * (j))
#define XB_TOP      3328
#define XB_TOPGEN   3392
#define XCD_BAR_WORDS 3456
#define XB_SPIN_CAP (1u << 22)
__device__ __forceinline__ unsigned xb_ld(unsigned* p)              { return __hip_atomic_load(p, __ATOMIC_RELAXED, __HIP_MEMORY_SCOPE_AGENT); }
__device__ __forceinline__ unsigned xb_add(unsigned* p, unsigned v) { return __hip_atomic_fetch_add(p, v, __ATOMIC_RELAXED, __HIP_MEMORY_SCOPE_AGENT); }
__device__ __forceinline__ unsigned xb_xcc_id() { return (unsigned)__builtin_amdgcn_s_getreg((3 << 11) | 20) & 0xFu; }
#define XB_SPIN(cond, bar) do { unsigned _sp = 0; while (cond) { __builtin_amdgcn_s_sleep(1); \
    if ((++_sp & 255u) == 0u) { if (xb_ld(&(bar)[XB_TMO])) break; if (_sp > XB_SPIN_CAP) { atomicAdd(&(bar)[XB_TMO], 1u); break; } } } } while (0)
struct XcdBarrier { unsigned* bar; unsigned x; volatile LAS unsigned* st; };
__device__ __forceinline__ XcdBarrier xcd_barrier_post(unsigned* bar, volatile LAS unsigned* st) {
    XcdBarrier b; b.bar = bar; b.x = xb_xcc_id(); b.st = st;
    if (threadIdx.x == 0) (void)xb_add(&bar[XB_XCNT(b.x)], 1u);
    return b;
}
__device__ __forceinline__ void xcd_barrier_complete(unsigned* bar, unsigned x, unsigned& nloc, unsigned& nx) {
    const unsigned G = gridDim.x * gridDim.y * gridDim.z;
    unsigned sum, cnt, mine, sp = 0u;
    for (;;) {
        sum = 0u; cnt = 0u; mine = 0u;
#pragma unroll
        for (unsigned j = 0; j < 16; ++j) { const unsigned c = xb_ld(&bar[XB_XCNT(j)]); sum += c; cnt += (c > 0u) ? 1u : 0u; mine = (j == x) ? c : mine; }
        if (sum == G) break;
        __builtin_amdgcn_s_sleep(1);
        if ((++sp & 255u) == 0u) { if (xb_ld(&bar[XB_TMO])) break; if (sp > XB_SPIN_CAP) { atomicAdd(&bar[XB_TMO], 1u); break; } }
    }
    nloc = mine > 0u ? mine : 1u; nx = cnt > 0u ? cnt : 1u;
}
__device__ __forceinline__ void xcd_barrier(const XcdBarrier& b) {
    asm volatile("s_waitcnt vmcnt(0)" ::: "memory");
    __syncthreads();
    if (threadIdx.x == 0) {
        unsigned* bar = b.bar;
        __builtin_amdgcn_s_waitcnt(0);
        unsigned nloc = b.st[0], nx = b.st[1];
        if (nloc == 0u) { xcd_barrier_complete(bar, b.x, nloc, nx); b.st[0] = nloc; b.st[1] = nx; }
        const unsigned old = xb_add(&bar[XB_XSUB(b.x)], 1u);
        const unsigned gen = old / nloc;
        if (old + 1u == (gen + 1u) * nloc) {
            __builtin_amdgcn_fence(__ATOMIC_RELEASE, "agent");
            asm volatile("s_waitcnt vmcnt(0)" ::: "memory");
            const unsigned og = xb_add(&bar[XB_TOP], 1u);
            const unsigned tg = og / nx;
            if (og + 1u == (tg + 1u) * nx) xb_add(&bar[XB_TOPGEN], 1u);
            else XB_SPIN(xb_ld(&bar[XB_TOPGEN]) == tg, bar);
            __builtin_amdgcn_fence(__ATOMIC_ACQUIRE, "agent");
            xb_add(&bar[XB_XGEN(b.x)], 1u);
            asm volatile("s_waitcnt vmcnt(0)" ::: "memory");
        } else {
            XB_SPIN(xb_ld(&bar[XB_XGEN(b.x)]) == gen, bar);
            __builtin_amdgcn_fence(__ATOMIC_ACQUIRE, "agent");
            asm volatile("s_waitcnt vmcnt(0)" ::: "memory");
        }
    }
    __syncthreads();
}

namespace pg8 {
constexpr int BM = 256, BK = 64, HALF = 128, HTB = HALF * BK * 2, STAGE_BYTES = 8 * HTB, NXCD = 8, WGM = 8;
__host__ __device__ __forceinline__ int lds_byte(int r, int c) { const int st = (r >> 4) * 2 + (c >> 5), rr = r & 15, cc = c & 31, ob = rr * 64 + cc * 2; return st * 1024 + (ob ^ (((ob >> 9) & 1) << 5)); }
__host__ __device__ __forceinline__ void stage_rc(int b, int& R, int& C) { const int st = b / 1024, sb = b % 1024, swz = sb ^ (((sb >> 9) & 1) << 5); R = (st >> 1) * 16 + swz / 64; C = (st & 1) * 32 + (swz % 64) / 2; }
__host__ __device__ __forceinline__ int perm32(int rho) { const int n = rho >> 4, i = rho & 15; return 8 * (i >> 2) + 4 * n + (i & 3); }
struct Unit { int pm, pn, ord; };
struct Gemm { const bf16_t* A; const bf16_t* Bt; int M, N, K; const LAS int* gather; };
struct StaticOrder {
    int nM, nN, nwg, G, c, same;
    int tail_rows, tail_ncols; unsigned long long tail_map;
    __device__ void init(int M, int N, int G_, int c_) { nM = M / BM; nN = N / BM; nwg = nM * nN; G = G_; c = c_; same = 0; tail_rows = 0; tail_ncols = 0; tail_map = 0ull; }
    __device__ bool next(int i, Unit& u) const {
        const long L = (long)i * G + c;
        if (L >= nwg) { const long j = L - nwg; if (j >= (long)tail_rows * tail_ncols) return false;
            u.pm = nM + (int)(j / tail_ncols); u.pn = (int)((tail_map >> (4 * (int)(j % tail_ncols))) & 15ull); u.ord = i; return true; }
        int wgid = (int)L; { const int q = nwg / NXCD, r = nwg % NXCD, xcd = wgid % NXCD, off = wgid / NXCD; wgid = (xcd < r ? xcd * (q + 1) : r * (q + 1) + (xcd - r) * q) + off; }
        const int nig = WGM * nN, gid = wgid / nig, fm = gid * WGM, gsz = (nM - fm) < WGM ? (nM - fm) : WGM;
        u.pm = fm + ((wgid % nig) % gsz); u.pn = (wgid % nig) / gsz; u.ord = i; return true;
    }
};
constexpr int MOE_TAB_OFF = STAGE_BYTES, MOE_MAXU = 10, MOE_TPP = 320;
struct MoeOrder {
    const LAS int* tab; int ntiles, G, c;
    __device__ bool next(int i, Unit& u) const { const long L = (long)i * G + c; if (L >= (long)ntiles * 4 || i >= MOE_MAXU) return false;
        u.pm = __builtin_amdgcn_readfirstlane(tab[i]); u.pn = __builtin_amdgcn_readfirstlane(tab[MOE_MAXU + i]) * 4 + (int)(L & 3); u.ord = i; return true; }
};
__device__ __forceinline__ void moe_tab_fill(LAS unsigned char* lds, const int* tileE, int nt0, int nt1, const int* slotTok, const float* slotW, int slotcap, int G, int c) {
    LAS int* tab = (LAS int*)(lds + MOE_TAB_OFF); LAS int* tok = tab + 2 * MOE_MAXU; LAS float* w = (LAS float*)(tok + MOE_MAXU * 256);
    int tid = threadIdx.x; asm volatile("" : "+v"(tid));
    for (int e = tid; e < MOE_MAXU * 256; e += 512) { const int i = e >> 8, r = e & 255; const long L = (long)i * G + c;
        if (L < (long)(nt0 + nt1) * 4) { const int ct = (int)(L >> 2), k = ct >= nt0 ? 1 : 0, tile = ct - k * nt0;
            tok[e] = slotTok[(size_t)k * slotcap + tile * 256 + r]; w[e] = slotW[(size_t)k * slotcap + tile * 256 + r];
            if (r == 0) { tab[i] = k * MOE_TPP + tile; tab[MOE_MAXU + i] = tileE[k * 512 + tile]; } } }
}

template <class Epi, class Sched, bool GATHER>
__device__ __forceinline__ void gemm_phase(LAS unsigned char* lds, const Gemm g, const Sched& S, const Epi& E) {
    int tid = threadIdx.x; asm volatile("" : "+v"(tid));
    const int wid = __builtin_amdgcn_readfirstlane(tid >> 6), lane = tid & 63, wr = wid >> 2, wc = wid & 3, fr = lane & 15, fq = lane >> 4;
    const int K = g.K, nt = K / BK;
    unsigned voffB[2]; int RA[2]; unsigned CA2[2];
#pragma unroll
    for (int i = 0; i < 2; ++i) { int R, C; stage_rc(tid * 16 + i * 8192, R, C); const int Rb = Epi::PERM ? ((R & ~31) + perm32(R & 31)) : R;
        voffB[i] = (unsigned)(Rb * K + C) * 2u; RA[i] = R; CA2[i] = (unsigned)C * 2u; }
    const unsigned kstep = (unsigned)(BK * 2);
    const size_t hstep = (size_t)HALF * K * 2;
    const size_t tstep = 2 * hstep;
    const unsigned ldsw = (unsigned)wid * 1024u;
    const int aoff = lds_byte(wr * 64 + fr, fq * 8), boff = lds_byte(wc * 32 + fr, fq * 8);
    const char* const Ab = (const char*)g.A;
#define PG8_SA(b, h) (((b) * 2 + (h)) * HTB)
#define PG8_SB(b, h) ((4 + (b) * 2 + (h)) * HTB)
#define PG8_STAGE(bufoff, gbase, voff) do { _Pragma("unroll") for (int _i = 0; _i < 2; ++_i) \
        __builtin_amdgcn_global_load_lds((const unsigned*)((const char*)(gbase) + (voff)[_i]), (LAS unsigned*)(lds + (bufoff) + ldsw + _i * 8192), 16, 0, 0); } while (0)
#define PG8_STAGEA(bufoff, kofs, OFFS, h) do { _Pragma("unroll") for (int _i = 0; _i < 2; ++_i) \
        __builtin_amdgcn_global_load_lds((const unsigned*)(Ab + (size_t)((OFFS)[h][_i] + (kofs))), (LAS unsigned*)(lds + (bufoff) + ldsw + _i * 8192), 16, 0, 0); } while (0)
#define PG8_LDA(dst, b, h) do { _Pragma("unroll") for (int m = 0; m < 4; ++m) _Pragma("unroll") for (int k = 0; k < 2; ++k) dst[m][k] = *(const LAS bf16x8*)(lds + PG8_SA(b, h) + aoff + m * 2048 + k * 1024); } while (0)
#define PG8_LDB(dst, b, h) do { _Pragma("unroll") for (int n = 0; n < 2; ++n) _Pragma("unroll") for (int k = 0; k < 2; ++k) dst[n][k] = *(const LAS bf16x8*)(lds + PG8_SB(b, h) + boff + n * 2048 + k * 1024); } while (0)
#define PG8_MMA(ai, bj, At, Bt) do { __builtin_amdgcn_s_setprio(1); _Pragma("unroll") for (int m = 0; m < 4; ++m) _Pragma("unroll") for (int n = 0; n < 2; ++n) _Pragma("unroll") for (int k = 0; k < 2; ++k) \
        acc[ai][bj][m][n] = __builtin_amdgcn_mfma_f32_16x16x32_bf16(Bt[n][k], At[m][k], acc[ai][bj][m][n], 0, 0, 0); __builtin_amdgcn_s_setprio(0); } while (0)
#define PG8_WAIT_V(n) asm volatile("s_waitcnt vmcnt(" #n ")" ::: "memory")
#define PG8_WAIT_L(n) asm volatile("s_waitcnt lgkmcnt(" #n ")" ::: "memory")
#define PG8_BAR __builtin_amdgcn_s_barrier()
#define PG8_SCHED __builtin_amdgcn_sched_barrier(0)
#define PG8_MKOFF(u, OFFS) do { _Pragma("unroll") for (int _h = 0; _h < 2; ++_h) _Pragma("unroll") for (int _i = 0; _i < 2; ++_i) { int _row = (u).pm * BM + _h * HALF + RA[_i]; \
        if (GATHER) { const int _t = g.gather[(u).ord * 256 + _h * HALF + RA[_i]]; _row = _t < 0 ? 0 : _t; } (OFFS)[_h][_i] = (unsigned)_row * (unsigned)(K * 2) + CA2[_i]; } \
        asm volatile("" : "+v"((OFFS)[0][0]), "+v"((OFFS)[0][1]), "+v"((OFFS)[1][0]), "+v"((OFFS)[1][1])); } while (0)
    Unit cur, nxt; int ui = 0;
    if (!S.next(0, cur)) return;
    f32x4 acc[2][2][4][2];
#pragma unroll
    for (int a = 0; a < 2; ++a)
#pragma unroll
        for (int b = 0; b < 2; ++b)
#pragma unroll
            for (int m = 0; m < 4; ++m)
#pragma unroll
                for (int n = 0; n < 2; ++n) acc[a][b][m][n] = (f32x4){0.f, 0.f, 0.f, 0.f};
    bf16x8 At[4][2], B0[2][2], B1[2][2];
    unsigned AO[2][2], NO[2][2];
    PG8_MKOFF(cur, AO);
    const char* cB = (const char*)g.Bt + (size_t)cur.pn * tstep;
    PG8_STAGE(PG8_SB(0, 0), cB, voffB); PG8_STAGEA(PG8_SA(0, 0), 0u, AO, 0); PG8_STAGE(PG8_SB(0, 1), cB + hstep, voffB); PG8_STAGEA(PG8_SA(0, 1), 0u, AO, 1);
    if (wr == 1) PG8_BAR;
    PG8_WAIT_V(4); PG8_BAR;
    PG8_STAGE(PG8_SB(1, 0), cB + kstep, voffB); PG8_STAGEA(PG8_SA(1, 0), kstep, AO, 0); PG8_STAGE(PG8_SB(1, 1), cB + hstep + kstep, voffB);
    PG8_WAIT_V(6); PG8_BAR;
    for (;;) {
        const bool has_next = S.next(ui + 1, nxt);
        if (has_next) { PG8_MKOFF(nxt, NO); }
        else {
#pragma unroll
            for (int h = 0; h < 2; ++h)
#pragma unroll
                for (int i = 0; i < 2; ++i) NO[h][i] = AO[h][i];
        }
        const char* nB = has_next ? (const char*)g.Bt + (size_t)nxt.pn * tstep : cB;
        for (int t = 0; t < nt; t += 2) {
            const bool last = (t == nt - 2);
            const unsigned ka1 = (unsigned)(t + 1) * kstep;
            const unsigned ka2 = last ? 0u : (unsigned)(t + 2) * kstep; const char* b2 = last ? nB : cB + (size_t)(t + 2) * kstep;
            const unsigned ka3 = ka2 + kstep; const char* b3 = b2 + kstep;
            PG8_LDB(B0, 0, 0); PG8_SCHED; PG8_LDA(At, 0, 0); PG8_STAGEA(PG8_SA(1, 1), ka1, AO, 1);
            PG8_WAIT_L(8); PG8_BAR; PG8_WAIT_L(0); PG8_MMA(0, 0, At, B0); PG8_BAR; PG8_SCHED;
            if (last) {
#pragma unroll
                for (int h = 0; h < 2; ++h)
#pragma unroll
                    for (int i = 0; i < 2; ++i) AO[h][i] = NO[h][i];
            }
            PG8_LDB(B1, 0, 1); PG8_STAGE(PG8_SB(0, 0), b2, voffB);
            PG8_BAR; PG8_WAIT_L(0); PG8_MMA(0, 1, At, B1); PG8_BAR;
            PG8_LDA(At, 0, 1); PG8_STAGEA(PG8_SA(0, 0), ka2, AO, 0);
            PG8_BAR; PG8_WAIT_L(0); PG8_MMA(1, 0, At, B0); PG8_BAR; PG8_SCHED;
            PG8_STAGE(PG8_SB(0, 1), b2 + hstep, voffB);
            PG8_WAIT_V(6); PG8_BAR; PG8_MMA(1, 1, At, B1); PG8_BAR;
            PG8_LDB(B0, 1, 0); PG8_SCHED; PG8_LDA(At, 1, 0); PG8_STAGEA(PG8_SA(0, 1), ka2, AO, 1);
            PG8_WAIT_L(8); PG8_BAR; PG8_WAIT_L(0); PG8_MMA(0, 0, At, B0); PG8_BAR; PG8_SCHED;
            PG8_LDB(B1, 1, 1); PG8_STAGE(PG8_SB(1, 0), b3, voffB);
            PG8_BAR; PG8_WAIT_L(0); PG8_MMA(0, 1, At, B1); PG8_BAR;
            PG8_LDA(At, 1, 1); PG8_STAGEA(PG8_SA(1, 0), ka3, AO, 0);
            PG8_BAR; PG8_WAIT_L(0); PG8_MMA(1, 0, At, B0); PG8_BAR; PG8_SCHED;
            PG8_STAGE(PG8_SB(1, 1), b3 + hstep, voffB);
            PG8_WAIT_V(6); PG8_BAR; PG8_MMA(1, 1, At, B1); PG8_BAR;
        }
        E(acc, cur, wr, wc, fr, fq);
        if (!has_next) break;
#pragma unroll
        for (int a = 0; a < 2; ++a)
#pragma unroll
            for (int b = 0; b < 2; ++b)
#pragma unroll
                for (int m = 0; m < 4; ++m)
#pragma unroll
                    for (int n = 0; n < 2; ++n) acc[a][b][m][n] = (f32x4){0.f, 0.f, 0.f, 0.f};
        cur = nxt; cB = nB; ++ui;
    }
    PG8_WAIT_V(0);
    if (wr == 0) PG8_BAR;
    PG8_BAR;
#undef PG8_SA
#undef PG8_SB
#undef PG8_STAGE
#undef PG8_STAGEA
#undef PG8_LDA
#undef PG8_LDB
#undef PG8_MMA
#undef PG8_WAIT_V
#undef PG8_WAIT_L
#undef PG8_BAR
#undef PG8_SCHED
#undef PG8_MKOFF
}

struct EpiP {
    static constexpr bool PERM = true;
    bf16_t* O; int ldc; const LAS f32x2* CS;
    __device__ __forceinline__ void operator()(const f32x4 (&acc)[2][2][4][2], const Unit& u, int wr, int wc, int fr, int fq) const {
        const int row0 = u.pm * BM + wr * 64 + fr, col0 = u.pn * BM + wc * 32 + 8 * fq;
        const bool lat = u.pm < (TLAT / BM);
#pragma unroll
        for (int bj = 0; bj < 2; ++bj) {
            const int cb = u.pn * BM + bj * HALF;
            const bool isrope = lat && cb < 384;
            const bool isv = (cb == 384) || (cb >= 1024 && cb < 1280);
#pragma unroll
            for (int ai = 0; ai < 2; ++ai)
#pragma unroll
                for (int m = 0; m < 4; ++m) { const int row = row0 + ai * HALF + m * 16;
                    float v[8];
#pragma unroll
                    for (int j = 0; j < 4; ++j) { v[j] = acc[ai][bj][m][0][j]; v[4 + j] = acc[ai][bj][m][1][j]; }
                    if (isrope) {
                        const int t = row & (SEQL - 1), pos = (wc & 1) ? (t & 63) : (t >> 6);
                        const LAS f32x4* tp = (const LAS f32x4*)(CS + pos * 16 + 8 * (fq & 1));
#pragma unroll
                        for (int j2 = 0; j2 < 4; ++j2) { const f32x4 cs2 = tp[j2];
                            const float p0 = __shfl_xor(v[2 * j2], 32), p1 = __shfl_xor(v[2 * j2 + 1], 32);
                            v[2 * j2] = fq < 2 ? v[2 * j2] * cs2[0] - p0 * cs2[1] : p0 * cs2[1] + v[2 * j2] * cs2[0];
                            v[2 * j2 + 1] = fq < 2 ? v[2 * j2 + 1] * cs2[2] - p1 * cs2[3] : p1 * cs2[3] + v[2 * j2 + 1] * cs2[2]; }
                    }
                    if (isv) {
                        const int r64 = u.pm * BM + ai * HALF + wr * 64, tcol = m * 16 + fr, vc = cb + 64 * (wc >> 1), d0 = 32 * (wc & 1) + 8 * fq;
#pragma unroll
                        for (int j = 0; j < 8; ++j) O[(size_t)(r64 + d0 + j) * ldc + vc + tcol] = f2bf(v[j]);
                    } else {
                        u32x4 w; w.x = cvt_pk_bf16(v[0], v[1]); w.y = cvt_pk_bf16(v[2], v[3]); w.z = cvt_pk_bf16(v[4], v[5]); w.w = cvt_pk_bf16(v[6], v[7]);
                        *(u32x4*)(O + (size_t)row * ldc + col0 + bj * HALF) = w;
                    } }
        }
    }
};
struct EpiRes {
    static constexpr bool PERM = true;
    bf16_t* x; const float* gate; float* ssq; float gscale;
    __device__ __forceinline__ void operator()(const f32x4 (&acc)[2][2][4][2], const Unit& u, int wr, int wc, int fr, int fq) const {
        if (gscale == 0.0f) return;
        const int rowt = u.pm * BM, row0 = rowt + wr * 64 + fr, col0 = u.pn * BM + wc * 32 + 8 * fq;
        const float* gp = gate + (size_t)mod_row(rowt) * 6144 + col0;
        bf16_t* xo = x + (size_t)row0 * DM + col0;
        f32x4 gv[2][2];
#pragma unroll
        for (int bj = 0; bj < 2; ++bj)
#pragma unroll
            for (int n = 0; n < 2; ++n) gv[bj][n] = *(const f32x4*)(gp + bj * HALF + n * 4) * gscale;
#pragma unroll
        for (int ai = 0; ai < 2; ++ai) {
            u32x4 xv[4][2];
#pragma unroll
            for (int m = 0; m < 4; ++m)
#pragma unroll
                for (int bj = 0; bj < 2; ++bj) xv[m][bj] = *(const u32x4*)(xo + (size_t)(ai * HALF + m * 16) * DM + bj * HALF);
            asm volatile("" ::: "memory");
#pragma unroll
            for (int m = 0; m < 4; ++m) { float sq = 0.f;
#pragma unroll
                for (int bj = 0; bj < 2; ++bj) { const u32x4 xx = xv[m][bj];
                    const f32x4 o0 = (f32x4){lo_bf(xx.x), hi_bf(xx.x), lo_bf(xx.y), hi_bf(xx.y)} + gv[bj][0] * acc[ai][bj][m][0];
                    const f32x4 o1 = (f32x4){lo_bf(xx.z), hi_bf(xx.z), lo_bf(xx.w), hi_bf(xx.w)} + gv[bj][1] * acc[ai][bj][m][1];
                    u32x4 w; w.x = cvt_pk_bf16(o0[0], o0[1]); w.y = cvt_pk_bf16(o0[2], o0[3]); w.z = cvt_pk_bf16(o1[0], o1[1]); w.w = cvt_pk_bf16(o1[2], o1[3]);
                    *(u32x4*)(xo + (size_t)(ai * HALF + m * 16) * DM + bj * HALF) = w;
                    const float r0 = lo_bf(w.x), r1 = hi_bf(w.x), r2 = lo_bf(w.y), r3 = hi_bf(w.y), r4 = lo_bf(w.z), r5 = hi_bf(w.z), r6 = lo_bf(w.w), r7 = hi_bf(w.w);
                    sq += ((r0 * r0 + r1 * r1) + (r2 * r2 + r3 * r3)) + ((r4 * r4 + r5 * r5) + (r6 * r6 + r7 * r7)); }
                sq += __shfl_xor(sq, 16); sq += __shfl_xor(sq, 32);
                if (fq == 0) ssq[(size_t)(row0 + ai * HALF + m * 16) * 16 + u.pn * 4 + wc] = sq; }
            asm volatile("" ::: "memory");
        }
    }
};
struct EpiHid {
    static constexpr bool PERM = true;
    bf16_t* Hd;
    __device__ __forceinline__ void operator()(const f32x4 (&acc)[2][2][4][2], const Unit& u, int wr, int wc, int fr, int fq) const {
        const int row0 = u.pm * BM + wr * 64 + fr, col0 = (u.pn & 3) * 128 + wc * 32 + 8 * fq;
#pragma unroll
        for (int ai = 0; ai < 2; ++ai)
#pragma unroll
            for (int m = 0; m < 4; ++m) { float hv[8];
#pragma unroll
                for (int n = 0; n < 2; ++n)
#pragma unroll
                    for (int j = 0; j < 4; ++j) { const float gt = acc[ai][0][m][n][j], up = acc[ai][1][m][n][j]; hv[n * 4 + j] = siluf_(gt) * up; }
                u32x4 w; w.x = cvt_pk_bf16(hv[0], hv[1]); w.y = cvt_pk_bf16(hv[2], hv[3]); w.z = cvt_pk_bf16(hv[4], hv[5]); w.w = cvt_pk_bf16(hv[6], hv[7]);
                *(u32x4*)(Hd + (size_t)(row0 + ai * HALF + m * 16) * MHID + col0) = w; }
    }
};
struct EpiMoe2 {
    static constexpr bool PERM = true;
    bf16_t* y0; bf16_t* y1; const LAS int* slotTok; const LAS float* slotW; int dry;
    __device__ __forceinline__ void operator()(const f32x4 (&acc)[2][2][4][2], const Unit& u, int wr, int wc, int fr, int fq) const {
        if (dry) return;
        const int col0 = (u.pn & 3) * BM + wc * 32 + 8 * fq;
        bf16_t* y = u.pm >= MOE_TPP ? y1 : y0;
#pragma unroll
        for (int ai = 0; ai < 2; ++ai)
#pragma unroll
            for (int m = 0; m < 4; ++m) { const int r = u.ord * 256 + wr * 64 + fr + ai * HALF + m * 16; const int tk = slotTok[r]; const float wv = slotW[r];
                if (tk >= 0) { bf16_t* yp = y + (size_t)tk * DM + col0;
#pragma unroll
                    for (int bj = 0; bj < 2; ++bj) { const f32x4 v0 = wv * acc[ai][bj][m][0], v1 = wv * acc[ai][bj][m][1];
                        u32x4 o; o.x = cvt_pk_bf16(v0[0], v0[1]); o.y = cvt_pk_bf16(v0[2], v0[3]); o.z = cvt_pk_bf16(v1[0], v1[1]); o.w = cvt_pk_bf16(v1[2], v1[3]);
                        *(u32x4*)(yp + bj * HALF) = o; } } }
    }
};
}

struct Args { const float* in[32]; float* out; unsigned char* ws; int ph_lo, ph_hi, dup_mask, mix_types; };

struct Ctx {
    const float* const* in; float* out; unsigned char* ws; LAS unsigned char* lds;
    int tid, lane, wave, G, wg;
};

__device__ __forceinline__ void transpose_tile(const Ctx& c, const float* src, int ld_src, bf16_t* dst, int ld_dst) {
    LAS float* T = (LAS float*)(c.lds + c.wave * 16640);
    f32x4 v[16];
#pragma unroll
    for (int i = 0; i < 16; ++i) { const int p = c.lane + 64 * i, r = p >> 4, c4 = (p & 15) * 4; v[i] = *(const f32x4*)(src + (size_t)r * ld_src + c4); }
#pragma unroll
    for (int i = 0; i < 16; ++i) { const int p = c.lane + 64 * i, r = p >> 4, c4 = (p & 15) * 4; LAS float* t = T + r * 65 + c4; t[0] = v[i][0]; t[1] = v[i][1]; t[2] = v[i][2]; t[3] = v[i][3]; }
    asm volatile("s_waitcnt lgkmcnt(0)" ::: "memory"); __builtin_amdgcn_wave_barrier();
#pragma unroll
    for (int i = 0; i < 8; ++i) { const int q = c.lane + 64 * i, n = q >> 3, k8 = (q & 7) * 8; float x[8];
#pragma unroll
        for (int j = 0; j < 8; ++j) x[j] = T[(k8 + j) * 65 + n];
        u32x4 w; w.x = cvt_pk_bf16(x[0], x[1]); w.y = cvt_pk_bf16(x[2], x[3]); w.z = cvt_pk_bf16(x[4], x[5]); w.w = cvt_pk_bf16(x[6], x[7]);
        *(u32x4*)(dst + (size_t)n * ld_dst + k8) = w; }
    asm volatile("s_waitcnt lgkmcnt(0)" ::: "memory"); __builtin_amdgcn_wave_barrier();
}

__device__ __forceinline__ void phase_prologue(Ctx c) {
    { int t_ = threadIdx.x; asm volatile("" : "+v"(t_)); c.tid = t_; c.lane = t_ & 63; }
    bf16_t* WinT = (bf16_t*)(c.ws + WS_WINT); bf16_t* WoutT = (bf16_t*)(c.ws + WS_WOUTT); bf16_t* GluT = (bf16_t*)(c.ws + WS_GLUT);
    const int nWin = 2 * 16 * 44, nWout = 2 * 16 * 16, nGlu = 2 * 4 * 4;
    for (int it = c.wg * 8 + c.wave; it < nWin + nWout + nGlu; it += c.G * 8) {
        if (it < nWin) { const int l = it / (16 * 44), r = it % (16 * 44), kt = r / 44, ntl = r % 44;
            transpose_tile(c, c.in[8] + (size_t)l * DM * PW + (size_t)kt * 64 * PW + ntl * 64, PW, WinT + (size_t)l * PW * DM + (size_t)ntl * 64 * DM + kt * 64, DM); }
        else if (it < nWin + nWout) { const int j = it - nWin, l = j / 256, r = j % 256, kt = r / 16, ntl = r % 16;
            transpose_tile(c, c.in[9] + (size_t)l * DM * DM + (size_t)kt * 64 * DM + ntl * 64, DM, WoutT + (size_t)l * DM * DM + (size_t)ntl * 64 * DM + kt * 64, DM); }
        else { const int j = it - nWin - nWout, l = j / 16, r = j % 16, kt = r / 4, ntl = r % 4;
            transpose_tile(c, c.in[22] + (size_t)l * 65536 + (size_t)kt * 64 * 256 + ntl * 64, 256, GluT + (size_t)l * 65536 + (size_t)ntl * 64 * 256 + kt * 64, 256); }
    }
    __syncthreads();
    float* modv = (float*)(c.ws + WS_MODV);
    LAS float* cT = (LAS float*)c.lds;
    LAS float* red = (LAS float*)(c.lds + 512 * 36 * 4);
    for (int it = c.wg; it < 192; it += c.G) {
        const int l = it / 96, col0 = (it % 96) * 64;
        float acc[33];
#pragma unroll
        for (int r = 0; r < 33; ++r) acc[r] = 0.f;
        for (int half = 0; half < 2; ++half) {
            __syncthreads();
            for (int i = c.tid; i < 512 * 36; i += NTHR) { const int k = i / 36, r = i % 36; float v = 0.f;
                if (r < 32) v = c.in[1][(size_t)r * DM + half * 512 + k]; else if (r == 32) v = c.in[3][half * 512 + k];
                cT[i] = (r < 33) ? siluf_(v) : 0.f; }
            __syncthreads();
            const float* wp = c.in[4] + (size_t)l * DM * 6144 + (size_t)(half * 512 + c.wave * 64) * 6144 + col0 + c.lane;
#pragma unroll 16
            for (int k = 0; k < 64; ++k) {
                const float w = wp[(size_t)k * 6144];
                const LAS f32x4* cr = (const LAS f32x4*)(cT + (c.wave * 64 + k) * 36);
#pragma unroll
                for (int r4 = 0; r4 < 9; ++r4) { const f32x4 cv = cr[r4];
#pragma unroll
                    for (int j = 0; j < 4; ++j) if (r4 * 4 + j < 33) acc[r4 * 4 + j] += cv[j] * w; }
            }
        }
        __syncthreads();
        if (c.wave >= 4) {
#pragma unroll
            for (int r = 0; r < 33; ++r) red[((c.wave - 4) * 33 + r) * 64 + c.lane] = acc[r]; }
        __syncthreads();
        if (c.wave < 4) {
#pragma unroll
            for (int r = 0; r < 33; ++r) { const float v = acc[r] + red[(c.wave * 33 + r) * 64 + c.lane]; red[(c.wave * 33 + r) * 64 + c.lane] = v; } }
        __syncthreads();
        for (int i = c.tid; i < 33 * 64; i += NTHR) { const int r = i >> 6, cc = i & 63;
            const float v = (red[(0 * 33 + r) * 64 + cc] + red[(1 * 33 + r) * 64 + cc]) + (red[(2 * 33 + r) * 64 + cc] + red[(3 * 33 + r) * 64 + cc]);
            modv[((size_t)l * 33 + r) * 6144 + col0 + cc] = v + c.in[5][(size_t)l * 6144 + col0 + cc]; }
        __syncthreads();
    }
}

__device__ __forceinline__ void phase_norm1(Ctx c, int l) {
    { int t_ = threadIdx.x; asm volatile("" : "+v"(t_)); c.tid = t_; c.lane = t_ & 63; }
    const float* modv = (const float*)(c.ws + WS_MODV) + (size_t)l * 33 * 6144;
    const float* modp = (const float*)(c.ws + WS_MODV) + 5 * 1024;
    const float* nw = c.in[6] + (size_t)l * DM;
    bf16_t* H = (bf16_t*)(c.ws + WS_H);
    bf16_t* xw = (bf16_t*)(c.ws + WS_X);
    const bf16_t* Y = (const bf16_t*)(c.ws + WS_MIX); const bf16_t* Y1 = (const bf16_t*)(c.ws + WS_H);
    f32x4 wv[4];
#pragma unroll
    for (int j = 0; j < 4; ++j) wv[j] = *(const f32x4*)(nw + j * 256 + c.lane * 4);
    const int nw8 = c.G * 8;
    for (int row = c.wg * 8 + c.wave; row < TALL; row += 2 * nw8) {
        const int rowb = row + nw8; const bool hb = rowb < TALL; const int rb2 = hb ? rowb : row;
        f32x4 va[4], vb[4];
        if (l == 0) {
            const float* xa = row < TLAT ? c.in[0] + (size_t)row * DM : c.in[2] + (size_t)(row - TLAT) * DM;
            const float* xb = rb2 < TLAT ? c.in[0] + (size_t)rb2 * DM : c.in[2] + (size_t)(rb2 - TLAT) * DM;
#pragma unroll
            for (int j = 0; j < 4; ++j) { va[j] = *(const f32x4*)(xa + j * 256 + c.lane * 4); vb[j] = *(const f32x4*)(xb + j * 256 + c.lane * 4); }
        } else {
            const float* ga = modp + (size_t)mod_row(row) * 6144; const float* gb = modp + (size_t)mod_row(rb2) * 6144;
#pragma unroll
            for (int j = 0; j < 4; ++j) { const int cc = j * 256 + c.lane * 4;
                const u32x2 xa = *(const u32x2*)(xw + (size_t)row * DM + cc), xb = *(const u32x2*)(xw + (size_t)rb2 * DM + cc);
                const u32x2 ya = *(const u32x2*)(Y + (size_t)row * DM + cc), yb = *(const u32x2*)(Y + (size_t)rb2 * DM + cc);
                const u32x2 za = *(const u32x2*)(Y1 + (size_t)row * DM + cc), zb = *(const u32x2*)(Y1 + (size_t)rb2 * DM + cc);
                va[j] = (f32x4){lo_bf(xa.x), hi_bf(xa.x), lo_bf(xa.y), hi_bf(xa.y)} + *(const f32x4*)(ga + cc) * ((f32x4){lo_bf(ya.x), hi_bf(ya.x), lo_bf(ya.y), hi_bf(ya.y)} + (f32x4){lo_bf(za.x), hi_bf(za.x), lo_bf(za.y), hi_bf(za.y)});
                vb[j] = (f32x4){lo_bf(xb.x), hi_bf(xb.x), lo_bf(xb.y), hi_bf(xb.y)} + *(const f32x4*)(gb + cc) * ((f32x4){lo_bf(yb.x), hi_bf(yb.x), lo_bf(yb.y), hi_bf(yb.y)} + (f32x4){lo_bf(zb.x), hi_bf(zb.x), lo_bf(zb.y), hi_bf(zb.y)}); }
        }
#pragma unroll
        for (int j = 0; j < 4; ++j) { const int cc = j * 256 + c.lane * 4;
            u32x2 oa; oa.x = cvt_pk_bf16(va[j][0], va[j][1]); oa.y = cvt_pk_bf16(va[j][2], va[j][3]); *(u32x2*)(xw + (size_t)row * DM + cc) = oa;
            if (hb) { u32x2 ob; ob.x = cvt_pk_bf16(vb[j][0], vb[j][1]); ob.y = cvt_pk_bf16(vb[j][2], vb[j][3]); *(u32x2*)(xw + (size_t)rowb * DM + cc) = ob; } }
        const float* mpa = modv + (size_t)mod_row(row) * 6144; const float* mpb = modv + (size_t)mod_row(rb2) * 6144;
        f32x4 sha[4], sca[4], shb[4], scb[4];
#pragma unroll
        for (int j = 0; j < 4; ++j) { const int cc = j * 256 + c.lane * 4; sha[j] = *(const f32x4*)(mpa + cc); sca[j] = *(const f32x4*)(mpa + 1024 + cc); shb[j] = *(const f32x4*)(mpb + cc); scb[j] = *(const f32x4*)(mpb + 1024 + cc); }
        float sa = 0.f, sb = 0.f;
#pragma unroll
        for (int j = 0; j < 4; ++j) { sa += va[j][0] * va[j][0] + va[j][1] * va[j][1] + va[j][2] * va[j][2] + va[j][3] * va[j][3]; sb += vb[j][0] * vb[j][0] + vb[j][1] * vb[j][1] + vb[j][2] * vb[j][2] + vb[j][3] * vb[j][3]; }
        sa = wave_sum(sa); sb = wave_sum(sb);
        const float ra = rsqrtf(sa * (1.0f / DM) + NORM_EPS), rb = rsqrtf(sb * (1.0f / DM) + NORM_EPS);
#pragma unroll
        for (int j = 0; j < 4; ++j) { const int cc = j * 256 + c.lane * 4;
            const f32x4 ya = (va[j] * ra * wv[j]) * (sca[j] + 1.0f) + sha[j]; u32x2 o; o.x = cvt_pk_bf16(ya[0], ya[1]); o.y = cvt_pk_bf16(ya[2], ya[3]);
            *(u32x2*)(H + (size_t)row * DM + cc) = o;
            if (hb) { const f32x4 yb = (vb[j] * rb * wv[j]) * (scb[j] + 1.0f) + shb[j]; u32x2 o2; o2.x = cvt_pk_bf16(yb[0], yb[1]); o2.y = cvt_pk_bf16(yb[2], yb[3]);
                *(u32x2*)(H + (size_t)rowb * DM + cc) = o2; } }
    }
}

__device__ __forceinline__ int scan_row(int b, int dir, int si) {
    if (si < CTXL) return TLAT + b * CTXL + (dir ? (CTXL - 1 - si) : si);
    const int tt = si - CTXL; return b * SEQL + (dir ? (SEQL - 1 - tt) : tt);
}
__device__ __forceinline__ unsigned pack_bf2(float a, float b) { return cvt_pk_bf16(a, b); }
__device__ __forceinline__ void phase_hgrn(Ctx c, int l) {
    { int t_ = threadIdx.x; asm volatile("" : "+v"(t_)); c.tid = t_; c.lane = t_ & 63; }
    const bf16_t* P = (const bf16_t*)(c.ws + WS_P);
    bf16_t* S = (bf16_t*)(c.ws + WS_H);
    constexpr int RS = 72;
    LAS bf16_t* QD = (LAS bf16_t*)c.lds;
    LAS bf16_t* QP = QD + 64 * RS;
    LAS bf16_t* KI = QP + 64 * RS;
    LAS bf16_t* KT = KI + 160 * RS;
    LAS bf16_t* VT = KT + 64 * RS;
    LAS bf16_t* AT = VT + 64 * RS;
    LAS bf16_t* ST = AT + 64 * RS;
    LAS float* TOT = (LAS float*)(ST + 2 * 64 * RS);
    LAS float* DV = TOT + 512;
    const int w = c.wave, lane = c.lane, fr = lane & 15, g = lane >> 4;
    const int ib = w >> 1, vtl = w & 3, th = w >> 2;
    constexpr int NCH = (CTXL + SEQL) / 64;
    for (int it = c.wg; it < NBATCH * 4 * 2; it += c.G) {
        const int dir = it & 1, hd = (it >> 1) & 3, b = it >> 3;
        const int fcol = (dir ? C_CFB : C_CFF) + hd * 64 + lane, qcol = C_CQ + hd * 64 + lane, icol = C_CI + hd * 64 + lane;
        float lb = 0.f;
        if (l == 1) { const float a0 = c.in[12][(size_t)(dir * 2 + 0) * 256 + hd * 64 + lane], a1 = c.in[12][(size_t)(dir * 2 + 1) * 256 + hd * 64 + lane]; lb = 1.0f / (1.0f + __expf(a0 - a1)); }
        __syncthreads();
        for (int i = c.tid; i < 64 * RS / 2; i += NTHR) { ((LAS unsigned*)AT)[i] = 0u; ((LAS unsigned*)ST)[i] = 0u; }
        f32x4 sacc[2]; sacc[0] = (f32x4){0.f, 0.f, 0.f, 0.f}; sacc[1] = (f32x4){0.f, 0.f, 0.f, 0.f};
        int cur = 0;
        unsigned short rq[8], rf[8], ri[8];
#pragma unroll
        for (int j = 0; j < 8; ++j) { const bf16_t* pr = P + (size_t)scan_row(b, dir, 8 * w + j) * PW; rq[j] = pr[qcol]; rf[j] = pr[fcol]; ri[j] = pr[icol]; }
        for (int ch = 0; ch < NCH; ++ch) {
            const int seq0 = ch * 64;
            float qa[8], kk[8], cs[8]; float run = 0.f;
#pragma unroll
            for (int j = 0; j < 8; ++j) { const float x = bf2f(rf[j]), q = bf2f(rq[j]);
                const float rinv = __builtin_amdgcn_rcpf(1.0f + __builtin_amdgcn_exp2f(-1.4426950408889634f * x));
                const float f = lb + (1.0f - lb) * rinv; kk[j] = 1.0f - f; run += __builtin_amdgcn_logf(fmaxf(f, 1e-30f)); cs[j] = run;
                qa[j] = q * __builtin_amdgcn_rcpf(1.0f + __builtin_amdgcn_exp2f(-1.4426950408889634f * q)); }
            TOT[w * 64 + lane] = run;
            __syncthreads();
            float T8[8];
#pragma unroll
            for (int t = 0; t < 8; ++t) T8[t] = TOT[t * 64 + lane];
            const float r1 = T8[0] + T8[1], r2 = r1 + T8[2] + T8[3], r3 = r2 + T8[4] + T8[5], bend = r3 + T8[6] + T8[7];
            float off = 0.f;
#pragma unroll
            for (int t = 0; t < 8; ++t) off += (t < w) ? T8[t] : 0.f;
            const float r0o = ib == 0 ? 0.f : (ib == 1 ? r1 : (ib == 2 ? r2 : r3));
            const float rnx = ib == 0 ? r1 : (ib == 1 ? r2 : (ib == 2 ? r3 : bend));
            const float c0 = __builtin_amdgcn_exp2f(r0o), ct = __builtin_amdgcn_exp2f(bend - rnx);
            const float c1 = __builtin_amdgcn_exp2f(r1 - rnx), c2 = __builtin_amdgcn_exp2f(r2 - rnx), c3 = __builtin_amdgcn_exp2f(r3 - rnx);
            const int kdo = ib == 0 ? 0 : (ib == 1 ? 16 : (ib == 2 ? 48 : 96));
            float ktv[8];
#pragma unroll
            for (int j = 0; j < 8; ++j) { const int tau = 8 * w + j; const float bb = off + cs[j];
                const float qd = qa[j] * __builtin_amdgcn_exp2f(bb - r0o);
                QD[tau * RS + lane] = f2bf(qd);
                QP[tau * RS + lane] = f2bf(qd * c0);
                KI[(kdo + tau) * RS + lane] = f2bf(kk[j] * __builtin_amdgcn_exp2f(fminf(r0o - bb, 86.0f)));
                const float ke = kk[j] * __builtin_amdgcn_exp2f(rnx - bb);
                if (ib < 1) KI[(16 + tau) * RS + lane] = f2bf(ke * c1);
                if (ib < 2) KI[(48 + tau) * RS + lane] = f2bf(ke * c2);
                if (ib < 3) KI[(96 + tau) * RS + lane] = f2bf(ke * c3);
                ktv[j] = ke * ct; }
            { u32x4 wk, wv; wk.x = pack_bf2(ktv[0], ktv[1]); wk.y = pack_bf2(ktv[2], ktv[3]); wk.z = pack_bf2(ktv[4], ktv[5]); wk.w = pack_bf2(ktv[6], ktv[7]);
              wv.x = (unsigned)ri[0] | ((unsigned)ri[1] << 16); wv.y = (unsigned)ri[2] | ((unsigned)ri[3] << 16); wv.z = (unsigned)ri[4] | ((unsigned)ri[5] << 16); wv.w = (unsigned)ri[6] | ((unsigned)ri[7] << 16);
              *(LAS u32x4*)(KT + lane * RS + 8 * w) = wk; *(LAS u32x4*)(VT + lane * RS + 8 * w) = wv; }
            if (w == 0) DV[lane] = __builtin_amdgcn_exp2f(bend);
            __syncthreads();
            if (ch + 1 < NCH) {
#pragma unroll
                for (int j = 0; j < 8; ++j) { const bf16_t* pr = P + (size_t)scan_row(b, dir, seq0 + 64 + 8 * w + j) * PW; rq[j] = pr[qcol]; rf[j] = pr[fcol]; ri[j] = pr[icol]; }
            }
            const bool need_o = !(l == 1 && seq0 < CTXL);
            if (need_o) {
                for (int idx = w; idx < 10; idx += 8) {
                    const int i = idx < 1 ? 0 : (idx < 3 ? 1 : (idx < 6 ? 2 : 3)), j = idx - ((i * (i + 1)) >> 1);
                    const int koff = i == 0 ? 0 : (i == 1 ? 16 : (i == 2 ? 48 : 96));
                    const LAS bf16_t* ap = KI + (koff + 16 * j + fr) * RS + g * 8; const LAS bf16_t* bp = QD + (16 * i + fr) * RS + g * 8;
                    f32x4 cc = (f32x4){0.f, 0.f, 0.f, 0.f};
                    cc = __builtin_amdgcn_mfma_f32_16x16x32_bf16(*(const LAS bf16x8*)ap, *(const LAS bf16x8*)bp, cc, 0, 0, 0);
                    cc = __builtin_amdgcn_mfma_f32_16x16x32_bf16(*(const LAS bf16x8*)(ap + 32), *(const LAS bf16x8*)(bp + 32), cc, 0, 0, 0);
                    if (j == i) {
#pragma unroll
                        for (int r = 0; r < 4; ++r) if (g * 4 + r > fr) cc[r] = 0.f; }
                    u32x2 o; o.x = pack_bf2(cc[0], cc[1]); o.y = pack_bf2(cc[2], cc[3]);
                    *(LAS u32x2*)(AT + (16 * i + fr) * RS + 16 * j + g * 4) = o;
                }
            }
            __syncthreads();
            if (need_o) {
#pragma unroll
                for (int ii = 0; ii < 2; ++ii) { const int i = 2 * th + ii;
                    f32x4 acc = (f32x4){0.f, 0.f, 0.f, 0.f};
                    const LAS bf16_t* sp = ST + cur * 64 * RS + (16 * vtl + fr) * RS + g * 8; const LAS bf16_t* qp = QP + (16 * i + fr) * RS + g * 8;
                    acc = __builtin_amdgcn_mfma_f32_16x16x32_bf16(*(const LAS bf16x8*)sp, *(const LAS bf16x8*)qp, acc, 0, 0, 0);
                    acc = __builtin_amdgcn_mfma_f32_16x16x32_bf16(*(const LAS bf16x8*)(sp + 32), *(const LAS bf16x8*)(qp + 32), acc, 0, 0, 0);
                    const LAS bf16_t* vp = VT + (16 * vtl + fr) * RS + g * 8; const LAS bf16_t* ap = AT + (16 * i + fr) * RS + g * 8;
                    acc = __builtin_amdgcn_mfma_f32_16x16x32_bf16(*(const LAS bf16x8*)vp, *(const LAS bf16x8*)ap, acc, 0, 0, 0);
                    if (i >= 2) acc = __builtin_amdgcn_mfma_f32_16x16x32_bf16(*(const LAS bf16x8*)(vp + 32), *(const LAS bf16x8*)(ap + 32), acc, 0, 0, 0);
                    const int row = scan_row(b, dir, seq0 + 16 * i + fr);
                    u32x2 o; o.x = pack_bf2(acc[0], acc[1]); o.y = pack_bf2(acc[2], acc[3]);
                    *(u32x2*)(S + (size_t)dir * SPART + (size_t)row * 256 + hd * 64 + 16 * vtl + g * 4) = o; }
            }
#pragma unroll
            for (int k2 = 0; k2 < 2; ++k2) { const int kt = 2 * th + k2; const float d = DV[16 * kt + fr];
                sacc[k2] *= d;
                const LAS bf16_t* vp = VT + (16 * vtl + fr) * RS + g * 8; const LAS bf16_t* kp = KT + (16 * kt + fr) * RS + g * 8;
                sacc[k2] = __builtin_amdgcn_mfma_f32_16x16x32_bf16(*(const LAS bf16x8*)vp, *(const LAS bf16x8*)kp, sacc[k2], 0, 0, 0);
                sacc[k2] = __builtin_amdgcn_mfma_f32_16x16x32_bf16(*(const LAS bf16x8*)(vp + 32), *(const LAS bf16x8*)(kp + 32), sacc[k2], 0, 0, 0);
                LAS bf16_t* sn = ST + (cur ^ 1) * 64 * RS + (16 * vtl + g * 4) * RS + 16 * kt + fr;
#pragma unroll
                for (int r = 0; r < 4; ++r) sn[r * RS] = f2bf(sacc[k2][r]); }
            cur ^= 1;
        }
    }
}

typedef short bf16x4 __attribute__((ext_vector_type(4)));
__device__ __forceinline__ void phase_s5(Ctx c, int l) {
    { int t_ = threadIdx.x; asm volatile("" : "+v"(t_)); c.tid = t_; c.lane = t_ & 63; }
    const bf16_t* P = (const bf16_t*)(c.ws + WS_P);
    bf16_t* S = (bf16_t*)(c.ws + WS_H) + 2 * SPART;
    constexpr int CH = 32, BS = 132, XS = 136;
    LAS float* BU = (LAS float*)(c.lds + c.wave * 25600);
    LAS bf16_t* X = (LAS bf16_t*)(c.lds + c.wave * 25600 + CH * BS * 4);
    const int lane = c.lane, fr = lane & 15, g4 = lane >> 4;
    for (int it = c.wg * 4 + c.wave; it < NBATCH * 16 * 2; it += c.G * 4) {
        const int dir = it & 1, grp = (it >> 1) & 15, b = it >> 5;
        const size_t gbase = ((size_t)(l * 2 + dir) * 16 + grp) * 64;
        const float dt = expf(c.in[16][(size_t)(l * 2 + dir) * 16 + grp]);
        float ar, ai;
        { const float lr = c.in[14][gbase + lane], li = c.in[15][gbase + lane]; const float mag = expf(lr * dt); float sn, cs; sincosf(li * dt, &sn, &cs); ar = mag * cs; ai = mag * sn; }
        bf16x4 bh[8], bl[8];
#pragma unroll
        for (int nt = 0; nt < 4; ++nt) { const size_t pi = gbase + nt * 16 + fr;
            const float lr = c.in[14][pi], li = c.in[15][pi]; const float mag = expf(lr * dt); float sn, cs; sincosf(li * dt, &sn, &cs);
            const float pr = mag * cs, pim = mag * sn, den = lr * lr + li * li;
            const float kr = ((pr - 1.0f) * lr + pim * li) / den, ki = (pim * lr - (pr - 1.0f) * li) / den;
            const f32x4 br = *(const f32x4*)(c.in[17] + pi * 16 + g4 * 4), bi = *(const f32x4*)(c.in[18] + pi * 16 + g4 * 4);
            const f32x4 vr = kr * br - ki * bi, vi = kr * bi + ki * br;
            u32x2 h, lo2;
            h.x = cvt_pk_bf16(vr[0], vr[1]); h.y = cvt_pk_bf16(vr[2], vr[3]);
            lo2.x = cvt_pk_bf16(vr[0] - lo_bf(h.x), vr[1] - hi_bf(h.x)); lo2.y = cvt_pk_bf16(vr[2] - lo_bf(h.y), vr[3] - hi_bf(h.y));
            bh[nt] = __builtin_bit_cast(bf16x4, h); bl[nt] = __builtin_bit_cast(bf16x4, lo2);
            h.x = cvt_pk_bf16(vi[0], vi[1]); h.y = cvt_pk_bf16(vi[2], vi[3]);
            lo2.x = cvt_pk_bf16(vi[0] - lo_bf(h.x), vi[1] - hi_bf(h.x)); lo2.y = cvt_pk_bf16(vi[2] - lo_bf(h.y), vi[3] - hi_bf(h.y));
            bh[4 + nt] = __builtin_bit_cast(bf16x4, h); bl[4 + nt] = __builtin_bit_cast(bf16x4, lo2); }
        bf16x8 cf[4];
#pragma unroll
        for (int ks = 0; ks < 4; ++ks) { const int kap = ks * 32 + g4 * 8; const bool im = kap >= 64; const float* cp = (im ? c.in[20] : c.in[19]) + (((size_t)(l * 2 + dir) * 16 + grp) * 16 + fr) * 64 + (kap & 63);
            const f32x4 a = *(const f32x4*)cp, bq = *(const f32x4*)(cp + 4); const float sg = im ? -1.f : 1.f;
            u32x4 w; w.x = cvt_pk_bf16(sg * a[0], sg * a[1]); w.y = cvt_pk_bf16(sg * a[2], sg * a[3]); w.z = cvt_pk_bf16(sg * bq[0], sg * bq[1]); w.w = cvt_pk_bf16(sg * bq[2], sg * bq[3]);
            cf[ks] = __builtin_bit_cast(bf16x8, w); }
        float xr = 0.f, xi = 0.f;
        u32x2 un[2];
#pragma unroll
        for (int mt = 0; mt < 2; ++mt) un[mt] = *(const u32x2*)(P + (size_t)scan_row(b, dir, mt * 16 + fr) * PW + C_DU + grp * 16 + g4 * 4);
        constexpr int NCH = (CTXL + SEQL) / CH;
        for (int ch = 0; ch < NCH; ++ch) {
            const bf16x4 ua0 = __builtin_bit_cast(bf16x4, un[0]), ua1 = __builtin_bit_cast(bf16x4, un[1]);
            if (ch + 1 < NCH) {
#pragma unroll
                for (int mt = 0; mt < 2; ++mt) un[mt] = *(const u32x2*)(P + (size_t)scan_row(b, dir, (ch + 1) * CH + mt * 16 + fr) * PW + C_DU + grp * 16 + g4 * 4); }
#pragma unroll
            for (int nt = 0; nt < 8; ++nt) {
                f32x4 t0 = (f32x4){0.f, 0.f, 0.f, 0.f}, t1 = (f32x4){0.f, 0.f, 0.f, 0.f};
                t0 = __builtin_amdgcn_mfma_f32_16x16x16bf16_1k(ua0, bh[nt], t0, 0, 0, 0); t0 = __builtin_amdgcn_mfma_f32_16x16x16bf16_1k(ua0, bl[nt], t0, 0, 0, 0);
                t1 = __builtin_amdgcn_mfma_f32_16x16x16bf16_1k(ua1, bh[nt], t1, 0, 0, 0); t1 = __builtin_amdgcn_mfma_f32_16x16x16bf16_1k(ua1, bl[nt], t1, 0, 0, 0);
#pragma unroll
                for (int r = 0; r < 4; ++r) { BU[(g4 * 4 + r) * BS + nt * 16 + fr] = t0[r]; BU[(16 + g4 * 4 + r) * BS + nt * 16 + fr] = t1[r]; }
            }
            asm volatile("s_waitcnt lgkmcnt(0)" ::: "memory"); __builtin_amdgcn_wave_barrier();
            float br_[CH], bi_[CH];
#pragma unroll
            for (int t = 0; t < CH; ++t) { br_[t] = BU[t * BS + lane]; bi_[t] = BU[t * BS + 64 + lane]; }
#pragma unroll
            for (int t = 0; t < CH; ++t) { const float nr = ar * xr - ai * xi + br_[t], ni = ar * xi + ai * xr + bi_[t]; xr = nr; xi = ni;
                X[t * XS + lane] = f2bf(xr); X[t * XS + 64 + lane] = f2bf(xi); }
            asm volatile("s_waitcnt lgkmcnt(0)" ::: "memory"); __builtin_amdgcn_wave_barrier();
            if (!(l == 1 && ch * CH < CTXL)) {
#pragma unroll
                for (int tt = 0; tt < 2; ++tt) { f32x4 y = (f32x4){0.f, 0.f, 0.f, 0.f};
#pragma unroll
                    for (int ks = 0; ks < 4; ++ks) { const bf16x8 xf = *(const LAS bf16x8*)(X + (tt * 16 + fr) * XS + ks * 32 + g4 * 8); y = __builtin_amdgcn_mfma_f32_16x16x32_bf16(cf[ks], xf, y, 0, 0, 0); }
                    const int row2 = scan_row(b, dir, ch * CH + tt * 16 + fr);
                    u32x2 o; o.x = cvt_pk_bf16(y[0], y[1]); o.y = cvt_pk_bf16(y[2], y[3]);
                    *(u32x2*)(S + (size_t)dir * SPART + (size_t)row2 * 256 + grp * 16 + g4 * 4) = o; }
            }
            asm volatile("s_waitcnt lgkmcnt(0)" ::: "memory"); __builtin_amdgcn_wave_barrier();
        }
    }
}

struct KFrag { bf16x8 k00, k01, k10, k11; };
struct VFrag { bf16x8 v0, v1, v2, v3; };
__device__ __forceinline__ void k_load(KFrag& f, const bf16_t* P, unsigned k0, unsigned k1) {
    const char* Pb = (const char*)P;
    f.k00 = *(const bf16x8*)(Pb + (size_t)(k0 * 2u)); f.k01 = *(const bf16x8*)(Pb + (size_t)(k0 * 2u + 64u)); f.k10 = *(const bf16x8*)(Pb + (size_t)(k1 * 2u)); f.k11 = *(const bf16x8*)(Pb + (size_t)(k1 * 2u + 64u));
}
__device__ __forceinline__ void v_load(VFrag& f, const bf16_t* P, unsigned v) {
    const char* Pb = (const char*)P;
    f.v0 = *(const bf16x8*)(Pb + (size_t)(v * 2u)); f.v1 = *(const bf16x8*)(Pb + (size_t)(v * 2u + 16u * PW * 2u)); f.v2 = *(const bf16x8*)(Pb + (size_t)(v * 2u + 32u * PW * 2u)); f.v3 = *(const bf16x8*)(Pb + (size_t)(v * 2u + 48u * PW * 2u));
}
__device__ __forceinline__ void attn_qk(const KFrag& f, bf16x8 q0, bf16x8 q1, f32x4& s0, f32x4& s1) {
    s0 = (f32x4){0.f, 0.f, 0.f, 0.f}; s1 = (f32x4){0.f, 0.f, 0.f, 0.f};
    s0 = __builtin_amdgcn_mfma_f32_16x16x32_bf16(f.k00, q0, s0, 0, 0, 0); s1 = __builtin_amdgcn_mfma_f32_16x16x32_bf16(f.k10, q0, s1, 0, 0, 0);
    s0 = __builtin_amdgcn_mfma_f32_16x16x32_bf16(f.k01, q1, s0, 0, 0, 0); s1 = __builtin_amdgcn_mfma_f32_16x16x32_bf16(f.k11, q1, s1, 0, 0, 0);
}
__device__ __forceinline__ float xrow16_max(float x) {
    auto s = __builtin_amdgcn_permlane16_swap(__float_as_uint(x), __float_as_uint(x), false, false);
    x = fmaxf(__uint_as_float(s[0]), __uint_as_float(s[1]));
    auto t = __builtin_amdgcn_permlane32_swap(__float_as_uint(x), __float_as_uint(x), false, false);
    return fmaxf(__uint_as_float(t[0]), __uint_as_float(t[1]));
}
__device__ __forceinline__ float xrow16_sum(float x) {
    auto s = __builtin_amdgcn_permlane16_swap(__float_as_uint(x), __float_as_uint(x), false, false);
    x = __uint_as_float(s[0]) + __uint_as_float(s[1]);
    auto t = __builtin_amdgcn_permlane32_swap(__float_as_uint(x), __float_as_uint(x), false, false);
    return __uint_as_float(t[0]) + __uint_as_float(t[1]);
}
constexpr float ATT_THR = 11.5f;
template <bool NB> __device__ __forceinline__ void attn_sv(const VFrag& fv, f32x4 s0, f32x4 s1, const float (&bias)[8], float& m, float& l, f32x4 (&o)[4]) {
    constexpr float SC = 0.125f * 1.4426950408889634f;
    float s[8], p[8];
#pragma unroll
    for (int j = 0; j < 4; ++j) { s[j] = NB ? s0[j] * SC + bias[j] : s0[j] * SC; s[4 + j] = NB ? s1[j] * SC + bias[4 + j] : s1[j] * SC; }
#pragma unroll
    for (int j = 0; j < 8; ++j) p[j] = __builtin_amdgcn_exp2f(fminf(s[j] - m, 126.0f));
    float mx = fmaxf(fmaxf(fmaxf(s[0], s[1]), fmaxf(s[2], s[3])), fmaxf(fmaxf(s[4], s[5]), fmaxf(s[6], s[7])));
    mx = xrow16_max(mx);
    if (!__all(mx - m <= ATT_THR)) {
        const float mn = fmaxf(m, mx), alpha = __builtin_amdgcn_exp2f(m - mn);
        o[0] *= alpha; o[1] *= alpha; o[2] *= alpha; o[3] *= alpha; l *= alpha; m = mn;
#pragma unroll
        for (int j = 0; j < 8; ++j) p[j] = __builtin_amdgcn_exp2f(s[j] - mn);
    }
    l += ((p[0] + p[1]) + (p[2] + p[3])) + ((p[4] + p[5]) + (p[6] + p[7]));
    u32x4 pw; pw.x = cvt_pk_bf16(p[0], p[1]); pw.y = cvt_pk_bf16(p[2], p[3]); pw.z = cvt_pk_bf16(p[4], p[5]); pw.w = cvt_pk_bf16(p[6], p[7]);
    const bf16x8 pf = __builtin_bit_cast(bf16x8, pw);
    o[0] = __builtin_amdgcn_mfma_f32_16x16x32_bf16(fv.v0, pf, o[0], 0, 0, 0); o[1] = __builtin_amdgcn_mfma_f32_16x16x32_bf16(fv.v1, pf, o[1], 0, 0, 0);
    o[2] = __builtin_amdgcn_mfma_f32_16x16x32_bf16(fv.v2, pf, o[2], 0, 0, 0); o[3] = __builtin_amdgcn_mfma_f32_16x16x32_bf16(fv.v3, pf, o[3], 0, 0, 0);
}

template <int TYPE>
struct AttnItem {
    static constexpr bool SWA = (TYPE == 0 || TYPE == 2), LAT = (TYPE < 2);
    static constexpr int NQ = LAT ? 2 : 1, NL = LAT ? 9 : 0, NT = NL + 8;
    static constexpr int qc = SWA ? C_AQ : C_BQ, kc = SWA ? C_AK : C_BK, vc = SWA ? C_AV : C_BV, oc = SWA ? 0 : 256;
    const bf16_t* P; const LAS float* rpb; int b, qt, hh, fr, g, kk0, kcolo, vcolo;
    int q0pos;
    int r0, rs0, kc0, qcol, wsn;
    __device__ __forceinline__ void offs(int t, unsigned& k0, unsigned& k1, unsigned& v) const {
        const int kk1 = kk0 + 4;
        if (TYPE == 0 && t < NL) {
            const int key0 = q0pos - 128 + 32 * t;
            int p0 = key0 + kk0, p1 = key0 + kk1; p0 = p0 < 0 ? 0 : (p0 > SEQL - 1 ? SEQL - 1 : p0); p1 = p1 < 0 ? 0 : (p1 > SEQL - 1 ? SEQL - 1 : p1);
            int kg = key0 + g * 8; kg = kg < 0 ? 0 : (kg > SEQL - 8 ? SEQL - 8 : kg);
            const int vrow = b * SEQL + kg;
            k0 = (unsigned)(b * SEQL + p0) * PW + kcolo; k1 = (unsigned)(b * SEQL + p1) * PW + kcolo; v = (unsigned)((vrow & ~63) + fr) * PW + vcolo + (vrow & 63);
        } else if (TYPE == 1 && t < NL) {
            int rr = rs0 + t; rr = rr > 31 ? 31 : rr;
            const int rowb = b * SEQL + rr * 64;
            k0 = (unsigned)(rowb + kc0 + kk0) * PW + kcolo; k1 = (unsigned)(rowb + kc0 + kk1) * PW + kcolo; v = (unsigned)(rowb + fr) * PW + vcolo + kc0 + g * 8;
        } else {
            const int ti = t - NL, crow = TLAT + b * CTXL, kg = ti * 32 + g * 8;
            k0 = (unsigned)(crow + ti * 32 + kk0) * PW + kcolo; k1 = (unsigned)(crow + ti * 32 + kk1) * PW + kcolo; v = (unsigned)(crow + (kg & ~63) + fr) * PW + vcolo + (kg & 63);
        }
    }
    __device__ __forceinline__ int bias(float (&bs)[8], int t, int i) const {
        if (TYPE == 0 && t < NL) {
            const int key0 = q0pos - 128 + 32 * t, qb = q0pos + 16 * i, qpos = qb + fr;
            if (key0 + 32 <= 0 || key0 >= SEQL || key0 + 31 < qb - 128 || key0 > qb + 15 + 128) return 0;
            if (key0 >= 0 && key0 + 31 < SEQL && key0 >= qb + 15 - 128 && key0 + 31 <= qb + 128) return 1;
#pragma unroll
            for (int j = 0; j < 8; ++j) { const int kpos = key0 + g * 8 + j; const int d = qpos - kpos; bs[j] = (kpos >= 0 && kpos < SEQL && d <= 128 && d >= -128) ? 0.f : -1e30f; }
            return 2;
        } else if (TYPE == 1 && t < NL) {
            const int r = r0 + i, rr = rs0 + t; int rsi = r - 4; rsi = rsi < 0 ? 0 : (rsi > 24 ? 24 : rsi);
            if (rr < rsi || rr > rsi + 7) return 0;
#pragma unroll
            for (int j = 0; j < 8; ++j) { const int kcol = kc0 + g * 8 + j; const bool ok = (kcol >= wsn) && (kcol < wsn + 16); int ci = kcol - qcol + 15; ci = ci < 0 ? 0 : (ci > 30 ? 30 : ci);
                bs[j] = ok ? rpb[hh * 465 + (rr - r + 7) * 31 + ci] : -1e30f; }
            return 2;
        }
        return 1;
    }
    __device__ __forceinline__ void run(bf16_t* mix, const float* sink, int lane) {
        fr = lane & 15; g = lane >> 4; kk0 = (fr >> 2) * 8 + (fr & 3);
        const int kvh = SWA ? (hh >> 1) : hh;
        kcolo = kc + kvh * 64 + g * 8; vcolo = vc + kvh * 64;
        int qrow[NQ];
        if (TYPE == 0) { q0pos = qt * 32; qrow[0] = b * SEQL + q0pos; if (NQ > 1) qrow[NQ - 1] = qrow[0] + 16; }
        else if (TYPE == 1) { const int rp = qt >> 2, jb = qt & 3; r0 = 2 * rp; rs0 = r0 - 4; rs0 = rs0 < 0 ? 0 : (rs0 > 24 ? 24 : rs0);
            kc0 = jb == 0 ? 0 : (jb == 1 ? 8 : (jb == 2 ? 24 : 32)); qcol = jb * 16 + fr; wsn = qcol - 8; wsn = wsn < 0 ? 0 : (wsn > 48 ? 48 : wsn);
            qrow[0] = b * SEQL + r0 * 64 + jb * 16; if (NQ > 1) qrow[NQ - 1] = qrow[0] + 64; }
        else qrow[0] = TLAT + b * CTXL + qt * 16;
        bf16x8 q0[NQ], q1[NQ]; float m[NQ], l[NQ]; f32x4 o[NQ][4];
#pragma unroll
        for (int i = 0; i < NQ; ++i) { const bf16_t* qp = P + (size_t)(qrow[i] + fr) * PW + qc + hh * 64 + g * 8;
            q0[i] = *(const bf16x8*)qp; q1[i] = *(const bf16x8*)(qp + 32);
            m[i] = SWA ? sink[hh] * 1.4426950408889634f : -1e30f; l[i] = (SWA && g == 0) ? 1.f : 0.f;
#pragma unroll
            for (int dt = 0; dt < 4; ++dt) o[i][dt] = (f32x4){0.f, 0.f, 0.f, 0.f}; }
        KFrag kf; VFrag vv; unsigned vnext;
        { unsigned k0_, k1_; offs(0, k0_, k1_, vnext); k_load(kf, P, k0_, k1_); }
#define ATT_STEP(t) do { v_load(vv, P, vnext); f32x4 sa_[NQ], sb_[NQ]; _Pragma("unroll") for (int i = 0; i < NQ; ++i) attn_qk(kf, q0[i], q1[i], sa_[i], sb_[i]); \
            if ((t) + 1 < NT) { unsigned k0_, k1_; offs((t) + 1, k0_, k1_, vnext); k_load(kf, P, k0_, k1_); } \
            _Pragma("unroll") for (int i = 0; i < NQ; ++i) { float bs_[8]; const int bc_ = bias(bs_, (t), i); if (bc_ == 2) attn_sv<true>(vv, sa_[i], sb_[i], bs_, m[i], l[i], o[i]); else if (bc_ == 1) attn_sv<false>(vv, sa_[i], sb_[i], bs_, m[i], l[i], o[i]); } } while (0)
#pragma clang loop unroll(disable)
        for (int t = 0; t < NT; ++t) ATT_STEP(t);
#undef ATT_STEP
#pragma unroll
        for (int i = 0; i < NQ; ++i) {
            const float lt = xrow16_sum(l[i]);
            const float inv = 1.0f / lt;
            bf16_t* op = mix + (size_t)(qrow[i] + fr) * DM + oc + hh * 64 + g * 4;
#pragma unroll
            for (int dt = 0; dt < 4; ++dt) { u32x2 w; w.x = cvt_pk_bf16(o[i][dt][0] * inv, o[i][dt][1] * inv); w.y = cvt_pk_bf16(o[i][dt][2] * inv, o[i][dt][3] * inv); *(u32x2*)(op + dt * 16) = w; } }
    }
};

constexpr int ATT_LDS_RPB = 114688, ATT_LDS_CTR = ATT_LDS_RPB + 7680;
__device__ __forceinline__ void attn_setup(Ctx c, int l) {
    { int t_ = threadIdx.x; asm volatile("" : "+v"(t_)); c.tid = t_; c.lane = t_ & 63; }
    LAS float* rpb = (LAS float*)(c.lds + ATT_LDS_RPB);
    for (int i = c.tid; i < 4 * 15 * 31; i += NTHR) rpb[i] = c.in[11][(size_t)l * 1860 + i] * 1.4426950408889634f;
    if (c.tid == 0) *(LAS int*)(c.lds + ATT_LDS_CTR) = 0;
}
__device__ __forceinline__ void phase_attn(Ctx c, int l) {
    { int t_ = threadIdx.x; asm volatile("" : "+v"(t_)); c.tid = t_; c.lane = t_ & 63; }
    const bf16_t* P = (const bf16_t*)(c.ws + WS_P);
    bf16_t* mix = (bf16_t*)(c.ws + WS_MIX);
    const LAS float* rpb = (const LAS float*)(c.lds + ATT_LDS_RPB);
    LAS int* ctr = (LAS int*)(c.lds + ATT_LDS_CTR);
    const float* sink = c.in[10] + l * 4;
    const int lane = c.lane;
    const int xcd = c.wg & 7, wq = c.wg >> 3;
    const int perB = (l == 0) ? 20 : 16;
    const int nItems = 4 * perB;
    for (;;) {
        int q = 0; if (lane == 0) q = atomicAdd((int*)ctr, 1);
        q = __builtin_amdgcn_readfirstlane(q);
        if (q >= nItems) break;
        const int bi = q / perB, r = q % perB, b = xcd + 8 * bi;
        const int it = r < 16 ? (r >> 3) * 256 + wq * 8 + (r & 7) : 512 + wq * 4 + (r - 16);
        if (it < 256) { AttnItem<1> A; A.P = P; A.rpb = rpb; A.hh = it & 3; A.qt = it >> 2; A.b = b; A.run(mix, sink, lane); }
        else if (it < 512) { const int j = it - 256; AttnItem<0> A; A.P = P; A.rpb = rpb; A.hh = j & 3; A.qt = j >> 2; A.b = b; A.run(mix, sink, lane); }
        else if (it < 576) { const int j = it - 512; AttnItem<3> A; A.P = P; A.rpb = rpb; A.hh = j & 3; A.qt = j >> 2; A.b = b; A.run(mix, sink, lane); }
        else { const int j = it - 576; AttnItem<2> A; A.P = P; A.rpb = rpb; A.hh = j & 3; A.qt = j >> 2; A.b = b; A.run(mix, sink, lane); }
    }
}

__device__ __forceinline__ void phase_mix2(Ctx c, int l, int tmask) {
    { int t_ = threadIdx.x; asm volatile("" : "+v"(t_)); c.tid = t_; c.lane = t_ & 63; }
    const bf16_t* P = (const bf16_t*)(c.ws + WS_P);
    bf16_t* mix = (bf16_t*)(c.ws + WS_MIX);
    const bf16_t* S = (const bf16_t*)(c.ws + WS_H);
    LAS float* rpb = (LAS float*)c.lds;
    for (int i = c.tid; i < 4 * 15 * 31; i += NTHR) rpb[i] = c.in[11][(size_t)l * 1860 + i];
    __syncthreads();
    const float* sink = c.in[10] + l * 4;
    const int lane = c.lane, fr = lane & 15, g4 = lane >> 4;
    const int gw = c.wg * 8 + c.wave, nw = c.G * 8;
    const int nrows = (l == 0) ? TALL : TLAT;
    const int nGlu = nrows / 16;
    const int n3 = 0, n4 = n3 + nGlu, n5 = n4 + nrows / 4;
    LAS bf16_t* GLW = (LAS bf16_t*)(c.lds + 8192);
    { const bf16_t* GluT = (const bf16_t*)(c.ws + WS_GLUT) + (size_t)l * 65536;
      for (int i = c.tid; i < 8192; i += NTHR) { const int n = i >> 5, k8 = (i & 31) * 8; *(LAS u32x4*)(GLW + n * 264 + k8) = *(const u32x4*)(GluT + n * 256 + k8); } }
    __syncthreads();
    const int nExtra = n4 % nw, nwc = nw - nExtra, nGluMine = (n4 - gw + nw - 1) / nw, ncomb = n5 - n4;
    for (int n = 0;; ++n) {
        int it;
        if (n < nGluMine) it = gw + n * nw;
        else { if (gw < nExtra) break; const int j = (gw - nExtra) + (n - nGluMine) * nwc; if (j >= ncomb) break; it = n4 + j; }
        if (false) {}
        else if (it < n4) {
            if (!(tmask & 16)) continue;
            const int row0 = it * 16; const int row = row0 + fr;
            const float* dvec = c.in[21] + (size_t)l * 256; const float* gb = c.in[23] + (size_t)l * 256;
            bf16x8 zf[8];
#pragma unroll
            for (int ks = 0; ks < 8; ++ks) { const int k0 = ks * 32 + g4 * 8;
                const u32x4 uu = *(const u32x4*)(P + (size_t)row * PW + C_DU + k0), ya = *(const u32x4*)(S + 2 * SPART + (size_t)row * 256 + k0), yb = *(const u32x4*)(S + 3 * SPART + (size_t)row * 256 + k0);
                const f32x4 d0 = *(const f32x4*)(dvec + k0), d1 = *(const f32x4*)(dvec + k0 + 4);
                float z[8];
                z[0] = gelu_tanh(d0[0] * lo_bf(uu.x) + lo_bf(ya.x) + lo_bf(yb.x)); z[1] = gelu_tanh(d0[1] * hi_bf(uu.x) + hi_bf(ya.x) + hi_bf(yb.x));
                z[2] = gelu_tanh(d0[2] * lo_bf(uu.y) + lo_bf(ya.y) + lo_bf(yb.y)); z[3] = gelu_tanh(d0[3] * hi_bf(uu.y) + hi_bf(ya.y) + hi_bf(yb.y));
                z[4] = gelu_tanh(d1[0] * lo_bf(uu.z) + lo_bf(ya.z) + lo_bf(yb.z)); z[5] = gelu_tanh(d1[1] * hi_bf(uu.z) + hi_bf(ya.z) + hi_bf(yb.z));
                z[6] = gelu_tanh(d1[2] * lo_bf(uu.w) + lo_bf(ya.w) + lo_bf(yb.w)); z[7] = gelu_tanh(d1[3] * hi_bf(uu.w) + hi_bf(ya.w) + hi_bf(yb.w));
                u32x4 w; w.x = cvt_pk_bf16(z[0], z[1]); w.y = cvt_pk_bf16(z[2], z[3]); w.z = cvt_pk_bf16(z[4], z[5]); w.w = cvt_pk_bf16(z[6], z[7]);
                zf[ks] = __builtin_bit_cast(bf16x8, w); }
#pragma unroll
            for (int ntl = 0; ntl < 16; ++ntl) {
                f32x4 a = (f32x4){0.f, 0.f, 0.f, 0.f};
#pragma unroll
                for (int ks = 0; ks < 8; ++ks) { const bf16x8 wf = *(const LAS bf16x8*)(GLW + (ntl * 16 + fr) * 264 + ks * 32 + g4 * 8); a = __builtin_amdgcn_mfma_f32_16x16x32_bf16(wf, zf[ks], a, 0, 0, 0); }
                const int n0c = ntl * 16 + g4 * 4;
                const u32x4 zw = __builtin_bit_cast(u32x4, zf[ntl >> 1]);
                const int src = fr + 16 * ((ntl & 1) * 2 + (g4 >> 1));
                const unsigned w0 = __shfl(zw.x, src), w1 = __shfl(zw.y, src), w2 = __shfl(zw.z, src), w3 = __shfl(zw.w, src);
                const unsigned zlo = (g4 & 1) ? w2 : w0, zhi = (g4 & 1) ? w3 : w1;
                const f32x4 b0 = *(const f32x4*)(gb + n0c);
                const float z0 = lo_bf(zlo), z1 = hi_bf(zlo), z2 = lo_bf(zhi), z3 = hi_bf(zhi);
                u32x2 w; w.x = cvt_pk_bf16(z0 * sigmoidf_(a[0] + b0[0]), z1 * sigmoidf_(a[1] + b0[1])); w.y = cvt_pk_bf16(z2 * sigmoidf_(a[2] + b0[2]), z3 * sigmoidf_(a[3] + b0[3]));
                *(u32x2*)(mix + (size_t)row * DM + 768 + n0c) = w;
            }
        } else {
            if (!(tmask & 32)) continue;
            const int rowq = (it - n4) * 4; const int ch = lane * 4;
            u32x2 a[4], bq[4], gg[4];
#pragma unroll
            for (int q = 0; q < 4; ++q) { const int row = rowq + q; a[q] = *(const u32x2*)(S + (size_t)row * 256 + ch); bq[q] = *(const u32x2*)(S + SPART + (size_t)row * 256 + ch); gg[q] = *(const u32x2*)(P + (size_t)row * PW + C_CG + ch); }
            const f32x4 nwv = *(const f32x4*)(c.in[13] + (size_t)l * 64 + (ch & 63));
#pragma unroll
            for (int q = 0; q < 4; ++q) { const int row = rowq + q;
                float ov[4] = {lo_bf(a[q].x) + lo_bf(bq[q].x), hi_bf(a[q].x) + hi_bf(bq[q].x), lo_bf(a[q].y) + lo_bf(bq[q].y), hi_bf(a[q].y) + hi_bf(bq[q].y)};
                float ss = ov[0] * ov[0] + ov[1] * ov[1] + ov[2] * ov[2] + ov[3] * ov[3];
                ss += __shfl_xor(ss, 1); ss += __shfl_xor(ss, 2); ss += __shfl_xor(ss, 4); ss += __shfl_xor(ss, 8);
                const float rs = rsqrtf(ss * (1.0f / 64.0f) + NORM_EPS);
                const float gv[4] = {lo_bf(gg[q].x), hi_bf(gg[q].x), lo_bf(gg[q].y), hi_bf(gg[q].y)};
                float r4[4];
#pragma unroll
                for (int j = 0; j < 4; ++j) r4[j] = ov[j] * rs * nwv[j] * siluf_(gv[j]);
                u32x2 w; w.x = cvt_pk_bf16(r4[0], r4[1]); w.y = cvt_pk_bf16(r4[2], r4[3]);
                *(u32x2*)(mix + (size_t)row * DM + 512 + ch) = w; }
        }
    }
}

__device__ __forceinline__ void phase_convert(Ctx c, int l) {
    { int t_ = threadIdx.x; asm volatile("" : "+v"(t_)); c.tid = t_; c.lane = t_ & 63; }
    bf16_t* W1T = (bf16_t*)(c.ws + WS_W1T); bf16_t* W2T = (bf16_t*)(c.ws + WS_W2T);
    for (int it = c.wg * 8 + c.wave; it < NEXP * 384; it += c.G * 8) {
        const int e = it / 384, r = it % 384;
        if (r < 256) { const int u = r >> 7, rr = r & 127, kt = rr >> 3, ntl = rr & 7;
            const float* src = c.in[u ? 29 : 28] + ((size_t)l * NEXP + e) * DM * MHID + (size_t)kt * 64 * MHID + ntl * 64;
            const int col = ntl * 64, drow = (col >> 7) * 256 + u * 128 + (col & 127);
            transpose_tile(c, src, MHID, W1T + (size_t)e * 1024 * 1024 + (size_t)drow * 1024 + kt * 64, 1024); }
        else { const int rr = r - 256, kt = rr >> 4, ntl = rr & 15;
            const float* src = c.in[30] + ((size_t)l * NEXP + e) * MHID * DM + (size_t)kt * 64 * DM + ntl * 64;
            transpose_tile(c, src, DM, W2T + (size_t)e * 1024 * MHID + (size_t)ntl * 64 * MHID + kt * 64, MHID); }
    }
}

__device__ __forceinline__ void phase_norm2(Ctx c, int l) {
    { int t_ = threadIdx.x; asm volatile("" : "+v"(t_)); c.tid = t_; c.lane = t_ & 63; }
    constexpr int WSR = 1032;
    LAS bf16_t* WH = (LAS bf16_t*)c.lds; LAS bf16_t* WL = WH + 36 * WSR;
    LAS int* hist = (LAS int*)(c.lds + 2 * 36 * WSR * 2);
    for (int i = c.tid; i < 9 * 1024; i += NTHR) {
        int d, n0; f32x4 w;
        if (i < 1024) { d = i; n0 = 0; w = *(const f32x4*)(c.in[24] + ((size_t)l * DM + d) * 4); }
        else { const int j = i - 1024; d = j >> 3; n0 = 4 + (j & 7) * 4; w = *(const f32x4*)(c.in[26] + ((size_t)l * DM + d) * 32 + (j & 7) * 4); }
#pragma unroll
        for (int q = 0; q < 4; ++q) { const bf16_t hi = f2bf(w[q]); WH[(n0 + q) * WSR + d] = hi; WL[(n0 + q) * WSR + d] = f2bf(w[q] - bf2f(hi)); } }
    if (c.tid < 64) hist[c.tid] = 0;
    LAS int* tctr = hist + 64;
    if (c.tid == 64) *tctr = 0;
    __syncthreads();
    const int T = (l == 0) ? TALL : TLAT, RPW = T / NWG;
    const float* modv = (const float*)(c.ws + WS_MODV) + (size_t)l * 33 * 6144;
    const float* nw = c.in[7] + (size_t)l * DM;
    const bf16_t* X = (const bf16_t*)(c.ws + WS_X);
    bf16_t* H = (bf16_t*)(c.ws + WS_H);
    int* tokE = (int*)(c.ws + WS_TOKE); float* tokW = (float*)(c.ws + WS_TOKW);
    const int lane = c.lane, fr = lane & 15, g4 = lane >> 4;
    const float bz0 = fr < 4 ? c.in[25][l * 4 + fr] : c.in[27][l * 32 + fr - 4], bz1 = c.in[27][l * 32 + 12 + fr], bz2 = fr < 4 ? c.in[27][l * 32 + 28 + fr] : 0.f;
    const int nr1 = 16 + fr, nr2 = fr < 4 ? 32 + fr : 35;
    for (;;) {
        int tile = 0; if (lane == 0) tile = atomicAdd((int*)tctr, 1);
        tile = __builtin_amdgcn_readfirstlane(tile);
        if (tile >= RPW / 16) break;
        const int row0 = c.wg * RPW + tile * 16, row = row0 + fr;
        const bf16_t* xr = X + (size_t)row * DM + g4 * 8;
        float ss; { const f32x4 pv = *(const f32x4*)((const float*)(c.ws + WS_SSQ) + (size_t)row * 16 + g4 * 4); ss = (pv[0] + pv[1]) + (pv[2] + pv[3]); }
        ss += __shfl_xor(ss, 16); ss += __shfl_xor(ss, 32);
        const float rstd = rsqrtf(ss * (1.0f / DM) + NORM_EPS);
        const float* mp = modv + (size_t)mod_row(row0) * 6144 + g4 * 8;
        const float* nwp = nw + g4 * 8;
        f32x4 acc[3]; acc[0] = (f32x4){0.f, 0.f, 0.f, 0.f}; acc[1] = acc[0]; acc[2] = acc[0];
        u32x4 XR[8]; f32x4 L[2][6];
#define N2_LOADX(j, k0) do { XR[j] = *(const u32x4*)(xr + (k0)); } while (0)
#define N2_LOADC(buf, k0) do { L[buf][0] = *(const f32x4*)(nwp + (k0)); L[buf][1] = *(const f32x4*)(nwp + (k0) + 4); \
            L[buf][2] = *(const f32x4*)(mp + 3 * 1024 + (k0)); L[buf][3] = *(const f32x4*)(mp + 3 * 1024 + (k0) + 4); L[buf][4] = *(const f32x4*)(mp + 4 * 1024 + (k0)); L[buf][5] = *(const f32x4*)(mp + 4 * 1024 + (k0) + 4); } while (0)
#define N2_STEP(j, buf, k0) do { \
            const f32x4 x0_ = (f32x4){lo_bf(XR[j].x), hi_bf(XR[j].x), lo_bf(XR[j].y), hi_bf(XR[j].y)}, x1_ = (f32x4){lo_bf(XR[j].z), hi_bf(XR[j].z), lo_bf(XR[j].w), hi_bf(XR[j].w)}; \
            const f32x4 xa = (x0_ * rstd * L[buf][0]) * (L[buf][4] + 1.0f) + L[buf][2], xb = (x1_ * rstd * L[buf][1]) * (L[buf][5] + 1.0f) + L[buf][3]; \
            u32x4 hi; hi.x = cvt_pk_bf16(xa[0], xa[1]); hi.y = cvt_pk_bf16(xa[2], xa[3]); hi.z = cvt_pk_bf16(xb[0], xb[1]); hi.w = cvt_pk_bf16(xb[2], xb[3]); \
            *(u32x4*)(H + (size_t)row * DM + g4 * 8 + (k0)) = hi; \
            u32x4 lo; lo.x = cvt_pk_bf16(xa[0] - lo_bf(hi.x), xa[1] - hi_bf(hi.x)); lo.y = cvt_pk_bf16(xa[2] - lo_bf(hi.y), xa[3] - hi_bf(hi.y)); \
            lo.z = cvt_pk_bf16(xb[0] - lo_bf(hi.z), xb[1] - hi_bf(hi.z)); lo.w = cvt_pk_bf16(xb[2] - lo_bf(hi.w), xb[3] - hi_bf(hi.w)); \
            const bf16x8 ah = __builtin_bit_cast(bf16x8, hi), al = __builtin_bit_cast(bf16x8, lo); \
            { const bf16x8 bh = *(const LAS bf16x8*)(WH + fr * WSR + g4 * 8 + (k0)), bl = *(const LAS bf16x8*)(WL + fr * WSR + g4 * 8 + (k0)); \
              acc[0] = __builtin_amdgcn_mfma_f32_16x16x32_bf16(ah, bh, acc[0], 0, 0, 0); acc[0] = __builtin_amdgcn_mfma_f32_16x16x32_bf16(ah, bl, acc[0], 0, 0, 0); acc[0] = __builtin_amdgcn_mfma_f32_16x16x32_bf16(al, bh, acc[0], 0, 0, 0); } \
            { const bf16x8 bh = *(const LAS bf16x8*)(WH + nr1 * WSR + g4 * 8 + (k0)), bl = *(const LAS bf16x8*)(WL + nr1 * WSR + g4 * 8 + (k0)); \
              acc[1] = __builtin_amdgcn_mfma_f32_16x16x32_bf16(ah, bh, acc[1], 0, 0, 0); acc[1] = __builtin_amdgcn_mfma_f32_16x16x32_bf16(ah, bl, acc[1], 0, 0, 0); acc[1] = __builtin_amdgcn_mfma_f32_16x16x32_bf16(al, bh, acc[1], 0, 0, 0); } \
            { const bf16x8 bh = *(const LAS bf16x8*)(WH + nr2 * WSR + g4 * 8 + (k0)), bl = *(const LAS bf16x8*)(WL + nr2 * WSR + g4 * 8 + (k0)); \
              acc[2] = __builtin_amdgcn_mfma_f32_16x16x32_bf16(ah, bh, acc[2], 0, 0, 0); acc[2] = __builtin_amdgcn_mfma_f32_16x16x32_bf16(ah, bl, acc[2], 0, 0, 0); acc[2] = __builtin_amdgcn_mfma_f32_16x16x32_bf16(al, bh, acc[2], 0, 0, 0); } } while (0)
#pragma unroll
        for (int j = 0; j < 8; ++j) N2_LOADX(j, j * 32);
        N2_LOADC(0, 0); N2_LOADC(1, 32);
#pragma clang loop unroll(disable)
        for (int kb = 0; kb < 32; kb += 8) {
#pragma unroll
            for (int j = 0; j < 8; ++j) { const int ks = kb + j;
                N2_STEP(j, (j & 1), ks * 32);
                if (ks + 8 < 32) N2_LOADX(j, (ks + 8) * 32);
                if (ks + 2 < 32) N2_LOADC((j & 1), (ks + 2) * 32); }
        }
#undef N2_LOADX
#undef N2_LOADC
#undef N2_STEP
#pragma unroll
        for (int r = 0; r < 4; ++r) {
            const float v0 = acc[0][r] + bz0, v1 = acc[1][r] + bz1, v2 = acc[2][r] + bz2;
            const int gb = lane & 48;
            const float g0 = __shfl(v0, gb + 0), g1 = __shfl(v0, gb + 1), g2 = __shfl(v0, gb + 2), g3 = __shfl(v0, gb + 3);
            int gi = 0; float gm = g0; if (g1 > gm) { gm = g1; gi = 1; } if (g2 > gm) { gm = g2; gi = 2; } if (g3 > gm) { gm = g3; gi = 3; }
            const float gwt = 1.0f / (__expf(g0 - gm) + __expf(g1 - gm) + __expf(g2 - gm) + __expf(g3 - gm));
            float ev[8];
#pragma unroll
            for (int j = 0; j < 8; ++j) { const int n = 4 + 8 * gi + j, tj = n >> 4; const float send = tj == 0 ? v0 : (tj == 1 ? v1 : v2); ev[j] = __shfl(send, gb + (n & 15)); }
            int i1 = 0; float e1 = ev[0];
#pragma unroll
            for (int j = 1; j < 8; ++j) if (ev[j] > e1) { e1 = ev[j]; i1 = j; }
            int i2 = -1; float e2v = -3.0e38f;
#pragma unroll
            for (int j = 0; j < 8; ++j) if (j != i1 && ev[j] > e2v) { e2v = ev[j]; i2 = j; }
            const float ex = __expf(e2v - e1), w1 = gwt / (1.0f + ex), w2 = gwt * ex / (1.0f + ex);
            if (fr == 0) { const int rr = row0 + g4 * 4 + r, ea = gi * 8 + i1, eb = gi * 8 + i2; tokE[rr] = ea; tokE[TALL + rr] = eb; tokW[rr] = w1; tokW[TALL + rr] = w2;
                atomicAdd((int*)&hist[ea], 1); atomicAdd((int*)&hist[32 + eb], 1); }
        }
    }
    __syncthreads();
    if (c.tid < 64) ((int*)(c.ws + WS_HIST))[c.wg * 64 + c.tid] = hist[c.tid];
}

__device__ __forceinline__ void phase_sort(Ctx c, int l) {
    { int t_ = threadIdx.x; asm volatile("" : "+v"(t_)); c.tid = t_; c.lane = t_ & 63; }
    const int T = (l == 0) ? TALL : TLAT, RPW = T / NWG;
    LAS int* tot = (LAS int*)c.lds; LAS int* pre = tot + 64; LAS int* seg = pre + 64; LAS int* myE = seg + 64;
    const int* hist = (const int*)(c.ws + WS_HIST);
    const int* tokE = (const int*)(c.ws + WS_TOKE); const float* tokW = (const float*)(c.ws + WS_TOKW);
    int* slotTok = (int*)(c.ws + WS_SLOTTOK); float* slotW = (float*)(c.ws + WS_SLOTW);
    if (c.tid < 128) tot[c.tid] = 0;
    __syncthreads();
    { const int bin = c.tid & 63, part = c.tid >> 6; int t = 0, p = 0;
      for (int w = part * 32; w < part * 32 + 32; ++w) { const int h = hist[w * 64 + bin]; t += h; if (w < c.wg) p += h; }
      atomicAdd((int*)&tot[bin], t); atomicAdd((int*)&pre[bin], p); }
    for (int i = c.tid; i < 2 * RPW; i += NTHR) { const int k = i / RPW, r = i % RPW; myE[i] = tokE[k * TALL + c.wg * RPW + r]; }
    __syncthreads();
    if (c.tid < 2) { int run = 0; for (int e = 0; e < 32; ++e) { seg[c.tid * 32 + e] = run; run += (tot[c.tid * 32 + e] + 255) & ~255; }
        if (c.wg == 0) ((int*)(c.ws + WS_NTILES))[c.tid] = run >> 8; }
    __syncthreads();
    for (int i = c.tid; i < 2 * RPW; i += NTHR) { const int k = i / RPW, r = i % RPW, e = myE[i]; int rank = 0;
        for (int q = 0; q < r; ++q) rank += (myE[k * RPW + q] == e) ? 1 : 0;
        const int pos = seg[k * 32 + e] + pre[k * 32 + e] + rank; const int row = c.wg * RPW + r;
        slotTok[k * SLOTCAP + pos] = row; slotW[k * SLOTCAP + pos] = tokW[k * TALL + row]; }
    if (c.wg < 64) { const int bin = c.wg, k = bin >> 5; const int s0 = seg[bin] + tot[bin], s1 = seg[bin] + ((tot[bin] + 255) & ~255);
        for (int p = s0 + c.tid; p < s1; p += NTHR) { slotTok[k * SLOTCAP + p] = -1; slotW[k * SLOTCAP + p] = 0.f; }
        int* tileE = (int*)(c.ws + WS_TILEE) + k * 512;
        for (int t = (seg[bin] >> 8) + c.tid; t < (s1 >> 8); t += NTHR) tileE[t] = bin & 31; }
}

__device__ __forceinline__ void phase_final(Ctx c) {
    { int t_ = threadIdx.x; asm volatile("" : "+v"(t_)); c.tid = t_; c.lane = t_ & 63; }
    constexpr int NR = 4;
    const bf16_t* X = (const bf16_t*)(c.ws + WS_X); const float* nw = c.in[31];
    const float* modp = (const float*)(c.ws + WS_MODV) + (size_t)33 * 6144 + 5 * 1024;
    const bf16_t* Y = (const bf16_t*)(c.ws + WS_MIX); const bf16_t* Y1 = (const bf16_t*)(c.ws + WS_H);
    const int nw8 = c.G * 8;
    for (int row0 = c.wg * 8 + c.wave; row0 < TLAT; row0 += NR * nw8) {
        u32x4 xa[NR][2], ya[NR][2], za[NR][2];
#pragma unroll
        for (int q = 0; q < NR; ++q) { const int row = row0 + q * nw8;
#pragma unroll
            for (int j = 0; j < 2; ++j) { const int cc = j * 512 + c.lane * 8; xa[q][j] = *(const u32x4*)(X + (size_t)row * DM + cc); ya[q][j] = *(const u32x4*)(Y + (size_t)row * DM + cc); za[q][j] = *(const u32x4*)(Y1 + (size_t)row * DM + cc); } }
#pragma unroll
        for (int q = 0; q < NR; ++q) { const int row = row0 + q * nw8; const float* ga = modp + (size_t)mod_row(row) * 6144;
            f32x4 v[2][2]; float ss = 0.f;
#pragma unroll
            for (int j = 0; j < 2; ++j) { const int cc = j * 512 + c.lane * 8; const u32x4 xx = xa[q][j], yy = ya[q][j], zz = za[q][j];
                v[j][0] = (f32x4){lo_bf(xx.x), hi_bf(xx.x), lo_bf(xx.y), hi_bf(xx.y)} + *(const f32x4*)(ga + cc) * ((f32x4){lo_bf(yy.x), hi_bf(yy.x), lo_bf(yy.y), hi_bf(yy.y)} + (f32x4){lo_bf(zz.x), hi_bf(zz.x), lo_bf(zz.y), hi_bf(zz.y)});
                v[j][1] = (f32x4){lo_bf(xx.z), hi_bf(xx.z), lo_bf(xx.w), hi_bf(xx.w)} + *(const f32x4*)(ga + cc + 4) * ((f32x4){lo_bf(yy.z), hi_bf(yy.z), lo_bf(yy.w), hi_bf(yy.w)} + (f32x4){lo_bf(zz.z), hi_bf(zz.z), lo_bf(zz.w), hi_bf(zz.w)});
#pragma unroll
                for (int h = 0; h < 2; ++h) ss += (v[j][h][0] * v[j][h][0] + v[j][h][1] * v[j][h][1]) + (v[j][h][2] * v[j][h][2] + v[j][h][3] * v[j][h][3]); }
            ss = wave_sum(ss);
            const float rs = rsqrtf(ss * (1.0f / DM) + NORM_EPS);
#pragma unroll
            for (int j = 0; j < 2; ++j) { const int cc = j * 512 + c.lane * 8;
                *(f32x4*)(c.out + (size_t)row * DM + cc) = v[j][0] * rs * *(const f32x4*)(nw + cc);
                *(f32x4*)(c.out + (size_t)row * DM + cc + 4) = v[j][1] * rs * *(const f32x4*)(nw + cc + 4); } }
    }
}

#ifndef MIX_DUP_TYPES
#define MIX_DUP_TYPES 63
#endif
#ifndef DUP_MASK
#define DUP_MASK 0
#endif
constexpr int NPL = 9, NPH = 1 + 2 * NPL + 1;
#ifndef PHASE_MASK
#define PHASE_MASK 0xFFFF
#endif
#define HAS(k) (((PHASE_MASK) >> (k)) & 1)
__global__ void __launch_bounds__(NTHR, 2) fwd_kernel(Args args) {
    extern __shared__ __attribute__((aligned(16))) unsigned char lds_raw[];
    Ctx c; c.in = args.in; c.out = args.out; c.ws = args.ws; c.lds = (LAS unsigned char*)lds_raw;
    c.tid = threadIdx.x; c.lane = c.tid & 63; c.wave = __builtin_amdgcn_readfirstlane(c.tid >> 6); c.G = gridDim.x; c.wg = blockIdx.x;
    const int lo = args.ph_lo, hi = args.ph_hi;
    constexpr int dupm = (DUP_MASK), mixt = (MIX_DUP_TYPES);
    volatile LAS unsigned* bst = (volatile LAS unsigned*)(c.lds + LDS_BYTES - 16);
    XcdBarrier bar; bar.bar = (unsigned*)(c.ws + WS_BAR); bar.x = 0; bar.st = bst;
    if (hi - lo > 1) { if (c.tid == 0) { bst[0] = 0u; bst[1] = 0u; } __syncthreads(); bar = xcd_barrier_post((unsigned*)(c.ws + WS_BAR), bst); }
#define IN(k) (lo <= (k) && (k) < hi)
#define SEAM(k) do { if (IN(k) && IN((k) + 1)) xcd_barrier(bar); } while (0)
#define RUN(T, k, ...) do { if (HAS(T) && IN(k)) { _Pragma("clang loop unroll(disable)") for (int rep_ = 0; rep_ < 1 + ((dupm >> (T)) & 1); ++rep_) { if (rep_) xcd_barrier(bar); __VA_ARGS__; } } SEAM(k); } while (0)
    RUN(0, 0, phase_prologue(c));
    for (int l = 0; l < 2; ++l) {
        const int pb = 1 + l * NPL;
        const float* modv = (const float*)(c.ws + WS_MODV) + (size_t)l * 33 * 6144;
        RUN(1, pb + 0, phase_norm1(c, l));
        RUN(2, pb + 1, {
            pg8::Gemm g{(const bf16_t*)(c.ws + WS_H), (const bf16_t*)(c.ws + WS_WINT) + (size_t)l * PW * DM, TALL, PW, DM, nullptr};
            pg8::StaticOrder S;
            if (l == 0) S.init(TALL, PW, c.G, c.wg);
            else { S.init(TLAT, PW, c.G, c.wg); S.tail_rows = TCTX / 256; S.tail_ncols = 7; S.tail_map = 0xA876431ull; }
            LAS f32x2* CS = (LAS f32x2*)(c.lds + pg8::STAGE_BYTES);
            { int t_ = threadIdx.x; asm volatile("" : "+v"(t_));
              for (int e = t_; e < 64 * 16; e += NTHR) { const int pos = e >> 4, i = e & 15; const float inv = __expf(-(float)i * (9.210340371976184f / 16.0f)); float sn, cs; sincosf((float)pos * inv, &sn, &cs); CS[e] = (f32x2){cs, sn}; } }
            __syncthreads();
            pg8::EpiP E{(bf16_t*)(c.ws + WS_P), PW, CS};
            pg8::gemm_phase<pg8::EpiP, pg8::StaticOrder, false>(c.lds, g, S, E); });
        RUN(3, pb + 2, { for (int r2 = 0; r2 < 1 + ((dupm >> 12) & 1); ++r2) { phase_hgrn(c, l); __syncthreads(); } attn_setup(c, l); __syncthreads();
            for (int r2 = 0; r2 < 1 + ((dupm >> 13) & 1); ++r2) { if (c.wave < 4) phase_s5(c, l); } phase_attn(c, l); });
        RUN(4, pb + 3, phase_mix2(c, l, rep_ ? mixt : 63));
        RUN(5, pb + 4, {
            const int M = (l == 0) ? TALL : TLAT;
            pg8::Gemm g{(const bf16_t*)(c.ws + WS_MIX), (const bf16_t*)(c.ws + WS_WOUTT) + (size_t)l * DM * DM, M, DM, DM, nullptr};
            pg8::StaticOrder S; S.init(M, DM, c.G, c.wg);
            const bool first = (rep_ == 0);
            pg8::EpiRes E{(bf16_t*)(c.ws + WS_X), modv + 2 * 1024, (float*)(c.ws + WS_SSQ), first ? 1.0f : 0.0f};
            pg8::gemm_phase<pg8::EpiRes, pg8::StaticOrder, false>(c.lds, g, S, E); });
        RUN(6, pb + 5, { _Pragma("clang loop unroll(disable)") for (int r2 = 0; r2 < 1 + ((dupm >> 14) & 1); ++r2) { phase_convert(c, l); __syncthreads(); } phase_norm2(c, l); });
        RUN(7, pb + 6, phase_sort(c, l));
        {
            const int vcu = (c.wg & 7) * (c.G >> 3) + (c.wg >> 3);
            const LAS int* mtab = (const LAS int*)(c.lds + pg8::MOE_TAB_OFF); const LAS int* mtok = mtab + 2 * pg8::MOE_MAXU; const LAS float* mw = (const LAS float*)(mtok + pg8::MOE_MAXU * 256);
            RUN(8, pb + 7, {
                const int nt0 = ((const int*)(c.ws + WS_NTILES))[0], nt1 = ((const int*)(c.ws + WS_NTILES))[1];
                pg8::moe_tab_fill(c.lds, (const int*)(c.ws + WS_TILEE), nt0, nt1, (const int*)(c.ws + WS_SLOTTOK), (const float*)(c.ws + WS_SLOTW), SLOTCAP, c.G, vcu); __syncthreads();
                pg8::Gemm g{(const bf16_t*)(c.ws + WS_H), (const bf16_t*)(c.ws + WS_W1T), 0, 0, DM, mtok};
                pg8::MoeOrder S{mtab, nt0 + nt1, c.G, vcu};
                pg8::EpiHid E{(bf16_t*)(c.ws + WS_HID)};
                pg8::gemm_phase<pg8::EpiHid, pg8::MoeOrder, true>(c.lds, g, S, E); });
            RUN(9, pb + 8, {
                const int nt0 = ((const int*)(c.ws + WS_NTILES))[0], nt1 = ((const int*)(c.ws + WS_NTILES))[1];
                pg8::moe_tab_fill(c.lds, (const int*)(c.ws + WS_TILEE), nt0, nt1, (const int*)(c.ws + WS_SLOTTOK), (const float*)(c.ws + WS_SLOTW), SLOTCAP, c.G, vcu); __syncthreads();
                pg8::Gemm g{(const bf16_t*)(c.ws + WS_HID), (const bf16_t*)(c.ws + WS_W2T), 0, 0, MHID, nullptr};
                pg8::MoeOrder S{mtab, nt0 + nt1, c.G, vcu};
                pg8::EpiMoe2 E{(bf16_t*)(c.ws + WS_MIX), (bf16_t*)(c.ws + WS_H), mtok, mw, rep_};
                pg8::gemm_phase<pg8::EpiMoe2, pg8::MoeOrder, false>(c.lds, g, S, E); });
        }
    }
    RUN(10, NPH - 1, phase_final(c));
#undef IN
#undef SEAM
#undef RUN
}

extern "C" void kernel_launch(void* const* d_in, const int* in_sizes, int n_in, void* d_out, int out_size, void* d_ws, size_t ws_size, hipStream_t stream) {
    static int grid = 0;
    if (grid == 0) {
        if (n_in != 32 || out_size != TLAT * DM || ws_size < WS_END) { fprintf(stderr, "kernel_launch: unexpected shapes (n_in %d out %d ws %zu)\n", n_in, out_size, ws_size); grid = -1; return; }
        int dev = 0, cus = 0, per_cu = 0;
        hipGetDevice(&dev); hipDeviceGetAttribute(&cus, hipDeviceAttributeMultiprocessorCount, dev);
        if (hipFuncSetAttribute((const void*)fwd_kernel, hipFuncAttributeMaxDynamicSharedMemorySize, LDS_BYTES) != hipSuccess) { fprintf(stderr, "kernel_launch: hipFuncSetAttribute failed\n"); grid = -1; return; }
        hipOccupancyMaxActiveBlocksPerMultiprocessor(&per_cu, (const void*)fwd_kernel, NTHR, LDS_BYTES);
        (void)hipGetLastError();
        if (cus != NWG || per_cu < 1) { fprintf(stderr, "kernel_launch: needs 256 CUs with one resident workgroup each (cus %d, per_cu %d)\n", cus, per_cu); grid = -1; return; }
        grid = NWG;
    }
    if (grid < 0) return;
    hipMemsetAsync((char*)d_ws + WS_BAR, 0, XCD_BAR_WORDS * sizeof(unsigned), stream);
    Args a{};
    for (int i = 0; i < 32; ++i) a.in[i] = (const float*)d_in[i];
    a.out = (float*)d_out; a.ws = (unsigned char*)d_ws; a.dup_mask = (DUP_MASK); a.mix_types = (MIX_DUP_TYPES);
#if N_LAUNCH_MODE == 1
    a.ph_lo = 0; a.ph_hi = NPH;
    hipLaunchKernelGGL(fwd_kernel, dim3(grid), dim3(NTHR), LDS_BYTES, stream, a);
#else
    for (int ph = 0; ph < NPH; ++ph) { a.ph_lo = ph; a.ph_hi = ph + 1; hipLaunchKernelGGL(fwd_kernel, dim3(grid), dim3(NTHR), LDS_BYTES, stream, a); }
#endif
}
```

```cpp
#include <hip/hip_runtime.h>
#include <stdint.h>
#include <type_traits>
#include <stdio.h>

#ifndef N_LAUNCH_MODE
#define N_LAUNCH_MODE 1
#endif

#define LAS __attribute__((address_space(3)))
typedef unsigned short bf16_t;
typedef short bf16x8 __attribute__((ext_vector_type(8)));
typedef float f32x4 __attribute__((ext_vector_type(4)));
typedef float f32x2 __attribute__((ext_vector_type(2)));
typedef unsigned u32x4 __attribute__((ext_vector_type(4)));
typedef unsigned u32x2 __attribute__((ext_vector_type(2)));

constexpr int DM = 1024, NBATCH = 32, SEQL = 2048, CTXL = 256;
constexpr int TLAT = NBATCH * SEQL, TCTX = NBATCH * CTXL, TALL = TLAT + TCTX;
constexpr int PW = 2816;
constexpr int C_AQ = 0, C_AK = 256, C_AV = 384, C_BQ = 512, C_BK = 768, C_BV = 1024, C_CQ = 1280, C_CFF = 1536, C_CFB = 1792, C_CI = 2048, C_CG = 2304, C_DU = 2560;
constexpr int NEXP = 32, MHID = 512;
constexpr int SLOTCAP = TALL + NEXP * 256;
constexpr int NWG = 256, NTHR = 512;
constexpr int LDS_BYTES = 153600;
constexpr float NORM_EPS = 1e-6f;

constexpr size_t MB = 1024ull * 1024ull;
constexpr size_t WS_BAR = 0;
constexpr size_t WS_NTILES = 32 * 1024;
constexpr size_t WS_TILEE = 36 * 1024;
constexpr size_t WS_HIST = 64 * 1024;
constexpr size_t WS_MODV = 256 * 1024;
constexpr size_t WS_TOKE = 2 * MB;
constexpr size_t WS_TOKW = 2 * MB + 640 * 1024;
constexpr size_t WS_SLOTTOK = 3 * MB + 512 * 1024;
constexpr size_t WS_SLOTW = 4 * MB + 256 * 1024;
constexpr size_t WS_GLUT = 5 * MB;
constexpr size_t WS_WINT = 6 * MB;
constexpr size_t WS_WOUTT = 17 * MB;
constexpr size_t WS_X = 21 * MB;
constexpr size_t WS_H = 309 * MB;
constexpr size_t WS_P = 453 * MB;
constexpr size_t WS_MIX = 849 * MB;
constexpr size_t WS_SSQ = 993 * MB;
constexpr size_t WS_END = 998 * MB;
constexpr size_t WS_W1T = WS_P;
constexpr size_t WS_W2T = WS_P + 64 * MB;
constexpr size_t WS_HID = WS_P + 96 * MB;
constexpr size_t SPART = (size_t)TALL * 256;

__device__ __forceinline__ int lane_now() { int l_; asm volatile("v_mbcnt_lo_u32_b32 %0, -1, 0\n\tv_mbcnt_hi_u32_b32 %0, -1, %0" : "=v"(l_)); return l_; }
#define TID_NOW(wv) ((wv) * 64 + lane_now())
__device__ __forceinline__ float bf2f(bf16_t v) { return __uint_as_float(((unsigned)v) << 16); }
typedef __bf16 bf16x2_t __attribute__((ext_vector_type(2)));
__device__ __forceinline__ unsigned cvt_pk_bf16(float lo, float hi) { const f32x2 v = {lo, hi}; const bf16x2_t r = __builtin_convertvector(v, bf16x2_t); return __builtin_bit_cast(unsigned, r); }
__device__ __forceinline__ bf16_t f2bf(float f) { return (bf16_t)(cvt_pk_bf16(f, 0.f) & 0xffffu); }
__device__ __forceinline__ float lo_bf(unsigned w) { return __uint_as_float(w << 16); }
__device__ __forceinline__ float hi_bf(unsigned w) { return __uint_as_float(w & 0xffff0000u); }
__device__ __forceinline__ float wave_sum(float v) { for (int o = 32; o >= 1; o >>= 1) v += __shfl_xor(v, o); return v; }
__device__ __forceinline__ float sigmoidf_(float x) { return __builtin_amdgcn_rcpf(1.0f + __builtin_amdgcn_exp2f(-1.4426950408889634f * x)); }
__device__ __forceinline__ float siluf_(float x) { return x * sigmoidf_(x); }
__device__ __forceinline__ float gelu_tanh(float y) { return y * sigmoidf_(y * (1.5957691216057308f + 0.0713548162726009f * y * y)); }
__device__ __forceinline__ int mod_row(int row) { return row < TLAT ? (row >> 11) : 32; }

#define XB_TMO      128
#define XB_XCNT(j)  (256  + 64 * (j))
#define XB_XSUB(j)  (1280 + 64 * (j))
#define XB_XGEN(j)  (2304 + 64 * (j))
#define XB_TOP      3328
#define XB_TOPGEN   3392
#define XCD_BAR_WORDS 3456
#define XB_SPIN_CAP (1u << 22)
__device__ __forceinline__ unsigned xb_ld(unsigned* p)              { return __hip_atomic_load(p, __ATOMIC_RELAXED, __HIP_MEMORY_SCOPE_AGENT); }
__device__ __forceinline__ unsigned xb_add(unsigned* p, unsigned v) { return __hip_atomic_fetch_add(p, v, __ATOMIC_RELAXED, __HIP_MEMORY_SCOPE_AGENT); }
__device__ __forceinline__ unsigned xb_xcc_id() { return (unsigned)__builtin_amdgcn_s_getreg((3 << 11) | 20) & 0xFu; }
#define XB_SPIN(cond, bar) do { unsigned _sp = 0; while (cond) { __builtin_amdgcn_s_sleep(1); \
    if ((++_sp & 255u) == 0u) { if (xb_ld(&(bar)[XB_TMO])) break; if (_sp > XB_SPIN_CAP) { atomicAdd(&(bar)[XB_TMO], 1u); break; } } } } while (0)
struct XcdBarrier { unsigned* bar; unsigned x; volatile LAS unsigned* st; int wave; };
__device__ __forceinline__ XcdBarrier xcd_barrier_post(unsigned* bar, volatile LAS unsigned* st) {
    XcdBarrier b; b.bar = bar; b.x = xb_xcc_id(); b.st = st;
    if (threadIdx.x == 0) (void)xb_add(&bar[XB_XCNT(b.x)], 1u);
    return b;
}
__device__ __forceinline__ void xcd_barrier_complete(unsigned* bar, unsigned x, unsigned& nloc, unsigned& nx) {
    const unsigned G = gridDim.x * gridDim.y * gridDim.z;
    unsigned sum, cnt, mine, sp = 0u;
    for (;;) {
        sum = 0u; cnt = 0u; mine = 0u;
#pragma unroll
        for (unsigned j = 0; j < 16; ++j) { const unsigned c = xb_ld(&bar[XB_XCNT(j)]); sum += c; cnt += (c > 0u) ? 1u : 0u; mine = (j == x) ? c : mine; }
        if (sum == G) break;
        __builtin_amdgcn_s_sleep(1);
        if ((++sp & 255u) == 0u) { if (xb_ld(&bar[XB_TMO])) break; if (sp > XB_SPIN_CAP) { atomicAdd(&bar[XB_TMO], 1u); break; } }
    }
    nloc = mine > 0u ? mine : 1u; nx = cnt > 0u ? cnt : 1u;
}
__device__ __forceinline__ void xcd_barrier(const XcdBarrier& b) {
    asm volatile("s_waitcnt vmcnt(0)" ::: "memory");
    __syncthreads();
    if (TID_NOW(b.wave) == 0) {
        unsigned* bar = b.bar;
        __builtin_amdgcn_s_waitcnt(0);
        unsigned nloc = b.st[0], nx = b.st[1];
        if (nloc == 0u) { xcd_barrier_complete(bar, b.x, nloc, nx); b.st[0] = nloc; b.st[1] = nx; }
        const unsigned old = xb_add(&bar[XB_XSUB(b.x)], 1u);
        const unsigned gen = old / nloc;
        if (old + 1u == (gen + 1u) * nloc) {
            __builtin_amdgcn_fence(__ATOMIC_RELEASE, "agent");
            asm volatile("s_waitcnt vmcnt(0)" ::: "memory");
            const unsigned og = xb_add(&bar[XB_TOP], 1u);
            const unsigned tg = og / nx;
            if (og + 1u == (tg + 1u) * nx) xb_add(&bar[XB_TOPGEN], 1u);
            else XB_SPIN(xb_ld(&bar[XB_TOPGEN]) == tg, bar);
            __builtin_amdgcn_fence(__ATOMIC_ACQUIRE, "agent");
            xb_add(&bar[XB_XGEN(b.x)], 1u);
            asm volatile("s_waitcnt vmcnt(0)" ::: "memory");
        } else {
            XB_SPIN(xb_ld(&bar[XB_XGEN(b.x)]) == gen, bar);
            __builtin_amdgcn_fence(__ATOMIC_ACQUIRE, "agent");
            asm volatile("s_waitcnt vmcnt(0)" ::: "memory");
        }
    }
    __syncthreads();
}

namespace pg8 {
constexpr int BM = 256, BK = 64, HALF = 128, HTB = HALF * BK * 2, STAGE_BYTES = 8 * HTB, NXCD = 8, WGM = 8;
__host__ __device__ __forceinline__ int lds_byte(int r, int c) { const int st = (r >> 4) * 2 + (c >> 5), rr = r & 15, cc = c & 31, ob = rr * 64 + cc * 2; return st * 1024 + (ob ^ (((ob >> 9) & 1) << 5)); }
__host__ __device__ __forceinline__ void stage_rc(int b, int& R, int& C) { const int st = b / 1024, sb = b % 1024, swz = sb ^ (((sb >> 9) & 1) << 5); R = (st >> 1) * 16 + swz / 64; C = (st & 1) * 32 + (swz % 64) / 2; }
__host__ __device__ __forceinline__ int perm32(int rho) { const int n = rho >> 4, i = rho & 15; return 8 * (i >> 2) + 4 * n + (i & 3); }
struct Unit { int pm, pn, ord; };
struct Gemm { const bf16_t* A; const bf16_t* Bt; int M, N, K; const LAS int* gather; };
struct StaticOrder {
    int nM, nN, nwg, G, c, same;
    int tail_rows, tail_ncols; unsigned long long tail_map;
    __device__ void init(int M, int N, int G_, int c_) { nM = M / BM; nN = N / BM; nwg = nM * nN; G = G_; c = c_; same = 0; tail_rows = 0; tail_ncols = 0; tail_map = 0ull; }
    __device__ bool next(int i, Unit& u) const {
        const long L = (long)i * G + c;
        if (L >= nwg) { const long j = L - nwg; if (j >= (long)tail_rows * tail_ncols) return false;
            u.pm = nM + (int)(j / tail_ncols); u.pn = (int)((tail_map >> (4 * (int)(j % tail_ncols))) & 15ull); u.ord = i; return true; }
        int wgid = (int)L; { const int q = nwg / NXCD, r = nwg % NXCD, xcd = wgid % NXCD, off = wgid / NXCD; wgid = (xcd < r ? xcd * (q + 1) : r * (q + 1) + (xcd - r) * q) + off; }
        const int nig = WGM * nN, gid = wgid / nig, fm = gid * WGM, gsz = (nM - fm) < WGM ? (nM - fm) : WGM;
        u.pm = fm + ((wgid % nig) % gsz); u.pn = (wgid % nig) / gsz; u.ord = i; return true;
    }
};
constexpr int MOE_TAB_OFF = STAGE_BYTES, MOE_MAXU = 10, MOE_TPP = 320;
struct MoeOrder {
    const LAS int* tab; int ntiles, G, c;
    __device__ bool next(int i, Unit& u) const { const long L = (long)i * G + c; if (L >= (long)ntiles * 4 || i >= MOE_MAXU) return false;
        u.pm = __builtin_amdgcn_readfirstlane(tab[i]); u.pn = __builtin_amdgcn_readfirstlane(tab[MOE_MAXU + i]) * 4 + (int)(L & 3); u.ord = i; return true; }
};
__device__ __forceinline__ void moe_tab_fill(LAS unsigned char* lds, const int* tileE, int nt0, int nt1, const int* slotTok, const float* slotW, int slotcap, int G, int c, int wave) {
    LAS int* tab = (LAS int*)(lds + MOE_TAB_OFF); LAS int* tok = tab + 2 * MOE_MAXU; LAS float* w = (LAS float*)(tok + MOE_MAXU * 256);
    int tid = TID_NOW(wave); asm volatile("" : "+v"(tid));
    int tk_[5]; float wv_[5];
#pragma unroll
    for (int j = 0; j < 5; ++j) { const int e = tid + j * 512, i = e >> 8, r = e & 255; const long L = (long)i * G + c; tk_[j] = 0; wv_[j] = 0.f;
        if (L < (long)(nt0 + nt1) * 4) { const int ct = (int)(L >> 2), k = ct >= nt0 ? 1 : 0, tile = ct - k * nt0;
            tk_[j] = slotTok[(size_t)k * slotcap + tile * 256 + r]; wv_[j] = slotW[(size_t)k * slotcap + tile * 256 + r]; } }
#pragma unroll
    for (int j = 0; j < 5; ++j) { const int e = tid + j * 512, i = e >> 8, r = e & 255; const long L = (long)i * G + c;
        if (L < (long)(nt0 + nt1) * 4) { const int ct = (int)(L >> 2), k = ct >= nt0 ? 1 : 0, tile = ct - k * nt0;
            tok[e] = tk_[j]; w[e] = wv_[j];
            if (r == 0) { tab[i] = k * MOE_TPP + tile; tab[MOE_MAXU + i] = tileE[k * 512 + tile]; } } }
}

template <class Epi, class Sched, bool GATHER>
__device__ __forceinline__ void gemm_phase(LAS unsigned char* lds, const Gemm g, const Sched& S, const Epi& E, int wave) {
    int tid = TID_NOW(wave); asm volatile("" : "+v"(tid));
    const int wid = __builtin_amdgcn_readfirstlane(tid >> 6), lane = tid & 63, wr = wid >> 2, wc = wid & 3, fr = lane & 15, fq = lane >> 4;
    const int K = g.K, nt = K / BK;
    unsigned voffB[2]; int RA[2]; unsigned CA2[2];
#pragma unroll
    for (int i = 0; i < 2; ++i) { int R, C; stage_rc(tid * 16 + i * 8192, R, C); const int Rb = Epi::PERM ? ((R & ~31) + perm32(R & 31)) : R;
        voffB[i] = (unsigned)(Rb * K + C) * 2u; RA[i] = R; CA2[i] = (unsigned)C * 2u; }
    const unsigned kstep = (unsigned)(BK * 2);
    const size_t hstep = (size_t)HALF * K * 2;
    const size_t tstep = 2 * hstep;
    const unsigned ldsw = (unsigned)wid * 1024u;
    const int aoff = lds_byte(wr * 64 + fr, fq * 8), boff = lds_byte(wc * 32 + fr, fq * 8);
    const char* const Ab = (const char*)g.A;
#define PG8_SA(b, h) (((b) * 2 + (h)) * HTB)
#define PG8_SB(b, h) ((4 + (b) * 2 + (h)) * HTB)
#define PG8_STAGE(bufoff, gbase, voff) do { _Pragma("unroll") for (int _i = 0; _i < 2; ++_i) \
        __builtin_amdgcn_global_load_lds((const unsigned*)((const char*)(gbase) + (voff)[_i]), (LAS unsigned*)(lds + (bufoff) + ldsw + _i * 8192), 16, 0, 0); } while (0)
#define PG8_STAGEA(bufoff, kofs, OFFS, h) do { _Pragma("unroll") for (int _i = 0; _i < 2; ++_i) \
        __builtin_amdgcn_global_load_lds((const unsigned*)(Ab + (size_t)((OFFS)[h][_i] + (kofs))), (LAS unsigned*)(lds + (bufoff) + ldsw + _i * 8192), 16, 0, 0); } while (0)
#define PG8_LDA(dst, b, h) do { _Pragma("unroll") for (int m = 0; m < 4; ++m) _Pragma("unroll") for (int k = 0; k < 2; ++k) dst[m][k] = *(const LAS bf16x8*)(lds + PG8_SA(b, h) + aoff + m * 2048 + k * 1024); } while (0)
#define PG8_LDB(dst, b, h) do { _Pragma("unroll") for (int n = 0; n < 2; ++n) _Pragma("unroll") for (int k = 0; k < 2; ++k) dst[n][k] = *(const LAS bf16x8*)(lds + PG8_SB(b, h) + boff + n * 2048 + k * 1024); } while (0)
#define PG8_MMA(ai, bj, At, Bt) do { __builtin_amdgcn_s_setprio(1); _Pragma("unroll") for (int m = 0; m < 4; ++m) _Pragma("unroll") for (int n = 0; n < 2; ++n) _Pragma("unroll") for (int k = 0; k < 2; ++k) \
        acc[ai][bj][m][n] = __builtin_amdgcn_mfma_f32_16x16x32_bf16(Bt[n][k], At[m][k], acc[ai][bj][m][n], 0, 0, 0); __builtin_amdgcn_s_setprio(0); } while (0)
#define PG8_WAIT_V(n) asm volatile("s_waitcnt vmcnt(" #n ")" ::: "memory")
#define PG8_WAIT_L(n) asm volatile("s_waitcnt lgkmcnt(" #n ")" ::: "memory")
#define PG8_BAR __builtin_amdgcn_s_barrier()
#define PG8_SCHED __builtin_amdgcn_sched_barrier(0)
#define PG8_MKOFF(u, OFFS) do { _Pragma("unroll") for (int _h = 0; _h < 2; ++_h) _Pragma("unroll") for (int _i = 0; _i < 2; ++_i) { int _row = (u).pm * BM + _h * HALF + RA[_i]; \
        if (GATHER) { const int _t = g.gather[(u).ord * 256 + _h * HALF + RA[_i]]; _row = _t < 0 ? 0 : _t; } (OFFS)[_h][_i] = (unsigned)_row * (unsigned)(K * 2) + CA2[_i]; } \
        asm volatile("" : "+v"((OFFS)[0][0]), "+v"((OFFS)[0][1]), "+v"((OFFS)[1][0]), "+v"((OFFS)[1][1])); } while (0)
    Unit cur, nxt; int ui = 0;
    if (!S.next(0, cur)) return;
    f32x4 acc[2][2][4][2];
#pragma unroll
    for (int a = 0; a < 2; ++a)
#pragma unroll
        for (int b = 0; b < 2; ++b)
#pragma unroll
            for (int m = 0; m < 4; ++m)
#pragma unroll
                for (int n = 0; n < 2; ++n) acc[a][b][m][n] = (f32x4){0.f, 0.f, 0.f, 0.f};
    bf16x8 At[4][2], B0[2][2], B1[2][2];
    unsigned AO[2][2], NO[2][2];
    PG8_MKOFF(cur, AO);
    const char* cB = (const char*)g.Bt + (size_t)cur.pn * tstep;
    PG8_STAGE(PG8_SB(0, 0), cB, voffB); PG8_STAGEA(PG8_SA(0, 0), 0u, AO, 0); PG8_STAGE(PG8_SB(0, 1), cB + hstep, voffB); PG8_STAGEA(PG8_SA(0, 1), 0u, AO, 1);
    if (wr == 1) PG8_BAR;
    PG8_WAIT_V(4); PG8_BAR;
    PG8_STAGE(PG8_SB(1, 0), cB + kstep, voffB); PG8_STAGEA(PG8_SA(1, 0), kstep, AO, 0); PG8_STAGE(PG8_SB(1, 1), cB + hstep + kstep, voffB); PG8_STAGEA(PG8_SA(1, 1), kstep, AO, 1);
    PG8_WAIT_V(8); PG8_BAR;
    for (;;) {
        const bool has_next = S.next(ui + 1, nxt);
        if (has_next) { PG8_MKOFF(nxt, NO); }
        else {
#pragma unroll
            for (int h = 0; h < 2; ++h)
#pragma unroll
                for (int i = 0; i < 2; ++i) NO[h][i] = AO[h][i];
        }
        const char* nB = has_next ? (const char*)g.Bt + (size_t)nxt.pn * tstep : cB;
        for (int t = 0; t < nt; t += 2) {
            const bool last = (t == nt - 2); const int skipw = (ui > 0 && t == 0) ? 1 : 0;
            const unsigned ka1 = (unsigned)(t + 1) * kstep;
            const unsigned ka2 = last ? 0u : (unsigned)(t + 2) * kstep; const char* b2 = last ? nB : cB + (size_t)(t + 2) * kstep;
            const unsigned ka3 = ka2 + kstep; const char* b3 = b2 + kstep;
            PG8_LDB(B0, 0, 0); PG8_SCHED; PG8_LDA(At, 0, 0);
            PG8_WAIT_L(8); PG8_BAR; PG8_WAIT_L(0); PG8_MMA(0, 0, At, B0); PG8_BAR; PG8_SCHED;
            if (last) {
#pragma unroll
                for (int h = 0; h < 2; ++h)
#pragma unroll
                    for (int i = 0; i < 2; ++i) AO[h][i] = NO[h][i];
            }
            PG8_LDB(B1, 0, 1); PG8_STAGE(PG8_SB(0, 0), b2, voffB);
            PG8_BAR; PG8_WAIT_L(0); PG8_MMA(0, 1, At, B1); PG8_BAR;
            PG8_LDA(At, 0, 1); PG8_STAGEA(PG8_SA(0, 0), ka2, AO, 0);
            PG8_BAR; PG8_WAIT_L(0); PG8_MMA(1, 0, At, B0); PG8_BAR; PG8_SCHED;
            PG8_STAGE(PG8_SB(0, 1), b2 + hstep, voffB);
            asm volatile("v_cmp_ne_u32_e32 vcc, 0, %0\n\ts_nop 1\n\ts_cbranch_vccnz .Lpg8_skip%=\n\ts_waitcnt vmcnt(6)\n.Lpg8_skip%=:" :: "v"(skipw) : "memory", "vcc");
            PG8_BAR; PG8_MMA(1, 1, At, B1); PG8_BAR;
            PG8_LDB(B0, 1, 0); PG8_SCHED; PG8_LDA(At, 1, 0); PG8_STAGEA(PG8_SA(0, 1), ka2, AO, 1);
            PG8_WAIT_L(8); PG8_BAR; PG8_WAIT_L(0); PG8_MMA(0, 0, At, B0); PG8_BAR; PG8_SCHED;
            PG8_LDB(B1, 1, 1); PG8_STAGE(PG8_SB(1, 0), b3, voffB);
            PG8_BAR; PG8_WAIT_L(0); PG8_MMA(0, 1, At, B1); PG8_BAR;
            PG8_LDA(At, 1, 1); PG8_STAGEA(PG8_SA(1, 0), ka3, AO, 0);
            PG8_BAR; PG8_WAIT_L(0); PG8_MMA(1, 0, At, B0); PG8_BAR; PG8_SCHED;
            PG8_STAGE(PG8_SB(1, 1), b3 + hstep, voffB); PG8_STAGEA(PG8_SA(1, 1), ka3, AO, 1);
            PG8_WAIT_V(8); PG8_BAR; PG8_MMA(1, 1, At, B1); PG8_BAR;
        }
        PG8_WAIT_V(0); PG8_BAR;
        E(acc, cur, wr, wc, fr, fq);
        if (!has_next) break;
#pragma unroll
        for (int a = 0; a < 2; ++a)
#pragma unroll
            for (int b = 0; b < 2; ++b)
#pragma unroll
                for (int m = 0; m < 4; ++m)
#pragma unroll
                    for (int n = 0; n < 2; ++n) acc[a][b][m][n] = (f32x4){0.f, 0.f, 0.f, 0.f};
        cur = nxt; cB = nB; ++ui;
    }
    PG8_WAIT_V(0);
    if (wr == 0) PG8_BAR;
    PG8_BAR;
#undef PG8_SA
#undef PG8_SB
#undef PG8_STAGE
#undef PG8_STAGEA
#undef PG8_LDA
#undef PG8_LDB
#undef PG8_MMA
#undef PG8_WAIT_V
#undef PG8_WAIT_L
#undef PG8_BAR
#undef PG8_SCHED
#undef PG8_MKOFF
}

struct EpiP {
    static constexpr bool PERM = true;
    bf16_t* O; int ldc; const LAS f32x2* CS;
    __device__ __forceinline__ void operator()(const f32x4 (&acc)[2][2][4][2], const Unit& u, int wr, int wc, int fr, int fq) const {
        const int row0 = u.pm * BM + wr * 64 + fr, col0 = u.pn * BM + wc * 32 + 8 * fq;
        const bool lat = u.pm < (TLAT / BM);
#pragma unroll
        for (int bj = 0; bj < 2; ++bj) {
            const int cb = u.pn * BM + bj * HALF;
            const bool isrope = lat && cb < 384;
            const bool isv = (cb == 384) || (cb >= 1024 && cb < 1280);
            const bool isq = (cb < 256) || (cb >= 512 && cb < 768);
#pragma unroll
            for (int ai = 0; ai < 2; ++ai)
#pragma unroll
                for (int m = 0; m < 4; ++m) { const int row = row0 + ai * HALF + m * 16;
                    float v[8];
#pragma unroll
                    for (int j = 0; j < 4; ++j) { v[j] = acc[ai][bj][m][0][j]; v[4 + j] = acc[ai][bj][m][1][j]; }
                    if (isrope) {
                        const int t = row & (SEQL - 1), pos = (wc & 1) ? (t & 63) : (t >> 6);
                        const LAS f32x4* tp = (const LAS f32x4*)(CS + pos * 16 + 8 * (fq & 1));
#pragma unroll
                        for (int j2 = 0; j2 < 4; ++j2) { const f32x4 cs2 = tp[j2];
                            const float p0 = __shfl_xor(v[2 * j2], 32), p1 = __shfl_xor(v[2 * j2 + 1], 32);
                            v[2 * j2] = fq < 2 ? v[2 * j2] * cs2[0] - p0 * cs2[1] : p0 * cs2[1] + v[2 * j2] * cs2[0];
                            v[2 * j2 + 1] = fq < 2 ? v[2 * j2 + 1] * cs2[2] - p1 * cs2[3] : p1 * cs2[3] + v[2 * j2 + 1] * cs2[2]; }
                    }
                    if (isq) {
#pragma unroll
                        for (int j = 0; j < 8; ++j) v[j] *= 0.125f * 1.4426950408889634f;
                    }
                    if (isv) {
                        const int r64 = u.pm * BM + ai * HALF + wr * 64, tcol = m * 16 + fr, vc = cb + 64 * (wc >> 1), d0 = 32 * (wc & 1) + 8 * fq;
#pragma unroll
                        for (int j = 0; j < 8; ++j) O[(size_t)(r64 + d0 + j) * ldc + vc + tcol] = f2bf(v[j]);
                    } else {
                        u32x4 w; w.x = cvt_pk_bf16(v[0], v[1]); w.y = cvt_pk_bf16(v[2], v[3]); w.z = cvt_pk_bf16(v[4], v[5]); w.w = cvt_pk_bf16(v[6], v[7]);
                        *(u32x4*)(O + (size_t)row * ldc + col0 + bj * HALF) = w;
                    } }
        }
    }
};
struct EpiRes {
    static constexpr bool PERM = true;
    bf16_t* x; const float* gate; float* ssq; float gscale;
    __device__ __forceinline__ void operator()(const f32x4 (&acc)[2][2][4][2], const Unit& u, int wr, int wc, int fr, int fq) const {
        if (gscale == 0.0f) return;
        const int rowt = u.pm * BM, row0 = rowt + wr * 64 + fr, col0 = u.pn * BM + wc * 32 + 8 * fq;
        const float* gp = gate + (size_t)mod_row(rowt) * 6144 + col0;
        bf16_t* xo = x + (size_t)row0 * DM + col0;
        f32x4 gv[2][2];
#pragma unroll
        for (int bj = 0; bj < 2; ++bj)
#pragma unroll
            for (int n = 0; n < 2; ++n) gv[bj][n] = *(const f32x4*)(gp + bj * HALF + n * 4) * gscale;
#pragma unroll
        for (int ai = 0; ai < 2; ++ai) {
            u32x4 xv[4][2];
#pragma unroll
            for (int m = 0; m < 4; ++m)
#pragma unroll
                for (int bj = 0; bj < 2; ++bj) xv[m][bj] = *(const u32x4*)(xo + (size_t)(ai * HALF + m * 16) * DM + bj * HALF);
            asm volatile("" ::: "memory");
#pragma unroll
            for (int m = 0; m < 4; ++m) { float sq = 0.f;
#pragma unroll
                for (int bj = 0; bj < 2; ++bj) { const u32x4 xx = xv[m][bj];
                    const f32x4 o0 = (f32x4){lo_bf(xx.x), hi_bf(xx.x), lo_bf(xx.y), hi_bf(xx.y)} + gv[bj][0] * acc[ai][bj][m][0];
                    const f32x4 o1 = (f32x4){lo_bf(xx.z), hi_bf(xx.z), lo_bf(xx.w), hi_bf(xx.w)} + gv[bj][1] * acc[ai][bj][m][1];
                    u32x4 w; w.x = cvt_pk_bf16(o0[0], o0[1]); w.y = cvt_pk_bf16(o0[2], o0[3]); w.z = cvt_pk_bf16(o1[0], o1[1]); w.w = cvt_pk_bf16(o1[2], o1[3]);
                    *(u32x4*)(xo + (size_t)(ai * HALF + m * 16) * DM + bj * HALF) = w;
                    const float r0 = lo_bf(w.x), r1 = hi_bf(w.x), r2 = lo_bf(w.y), r3 = hi_bf(w.y), r4 = lo_bf(w.z), r5 = hi_bf(w.z), r6 = lo_bf(w.w), r7 = hi_bf(w.w);
                    sq += ((r0 * r0 + r1 * r1) + (r2 * r2 + r3 * r3)) + ((r4 * r4 + r5 * r5) + (r6 * r6 + r7 * r7)); }
                sq += __shfl_xor(sq, 16); sq += __shfl_xor(sq, 32);
                if (fq == 0) ssq[(size_t)(row0 + ai * HALF + m * 16) * 16 + u.pn * 4 + wc] = sq; }
            asm volatile("" ::: "memory");
        }
    }
};
struct EpiHid {
    static constexpr bool PERM = true;
    bf16_t* Hd;
    __device__ __forceinline__ void operator()(const f32x4 (&acc)[2][2][4][2], const Unit& u, int wr, int wc, int fr, int fq) const {
        const int row0 = u.pm * BM + wr * 64 + fr, col0 = (u.pn & 3) * 128 + wc * 32 + 8 * fq;
#pragma unroll
        for (int ai = 0; ai < 2; ++ai)
#pragma unroll
            for (int m = 0; m < 4; ++m) { float hv[8];
#pragma unroll
                for (int n = 0; n < 2; ++n)
#pragma unroll
                    for (int j = 0; j < 4; ++j) { const float gt = acc[ai][0][m][n][j], up = acc[ai][1][m][n][j]; hv[n * 4 + j] = siluf_(gt) * up; }
                u32x4 w; w.x = cvt_pk_bf16(hv[0], hv[1]); w.y = cvt_pk_bf16(hv[2], hv[3]); w.z = cvt_pk_bf16(hv[4], hv[5]); w.w = cvt_pk_bf16(hv[6], hv[7]);
                *(u32x4*)(Hd + (size_t)(row0 + ai * HALF + m * 16) * MHID + col0) = w; }
    }
};
struct EpiMoe2 {
    static constexpr bool PERM = true;
    bf16_t* y0; bf16_t* y1; const LAS int* slotTok; const LAS float* slotW; int dry;
    __device__ __forceinline__ void operator()(const f32x4 (&acc)[2][2][4][2], const Unit& u, int wr, int wc, int fr, int fq) const {
        if (dry) return;
        const int col0 = (u.pn & 3) * BM + wc * 32 + 8 * fq;
        bf16_t* y = u.pm >= MOE_TPP ? y1 : y0;
#pragma unroll
        for (int ai = 0; ai < 2; ++ai)
#pragma unroll
            for (int m = 0; m < 4; ++m) { const int r = u.ord * 256 + wr * 64 + fr + ai * HALF + m * 16; const int tk = slotTok[r]; const float wv = slotW[r];
                if (tk >= 0) { bf16_t* yp = y + (size_t)tk * DM + col0;
#pragma unroll
                    for (int bj = 0; bj < 2; ++bj) { const f32x4 v0 = wv * acc[ai][bj][m][0], v1 = wv * acc[ai][bj][m][1];
                        u32x4 o; o.x = cvt_pk_bf16(v0[0], v0[1]); o.y = cvt_pk_bf16(v0[2], v0[3]); o.z = cvt_pk_bf16(v1[0], v1[1]); o.w = cvt_pk_bf16(v1[2], v1[3]);
                        *(u32x4*)(yp + bj * HALF) = o; } } }
    }
};
}

struct Args { const float* in[32]; float* out; unsigned char* ws; int ph_lo, ph_hi, dup_mask, mix_types; };

struct Ctx {
    const float* const* in; float* out; unsigned char* ws; LAS unsigned char* lds;
    int tid, lane, wave, G, wg;
};

__device__ __forceinline__ void transpose_tile(const Ctx& c, const float* src, int ld_src, bf16_t* dst, int ld_dst) {
    LAS float* T = (LAS float*)(c.lds + c.wave * 16640);
    f32x4 v[16];
#pragma unroll
    for (int i = 0; i < 16; ++i) { const int p = c.lane + 64 * i, r = p >> 4, c4 = (p & 15) * 4; v[i] = *(const f32x4*)(src + (size_t)r * ld_src + c4); }
#pragma unroll
    for (int i = 0; i < 16; ++i) { const int p = c.lane + 64 * i, r = p >> 4, c4 = (p & 15) * 4; LAS float* t = T + r * 65 + c4; t[0] = v[i][0]; t[1] = v[i][1]; t[2] = v[i][2]; t[3] = v[i][3]; }
    asm volatile("s_waitcnt lgkmcnt(0)" ::: "memory"); __builtin_amdgcn_wave_barrier();
#pragma unroll
    for (int i = 0; i < 8; ++i) { const int q = c.lane + 64 * i, n = q >> 3, k8 = (q & 7) * 8; float x[8];
#pragma unroll
        for (int j = 0; j < 8; ++j) x[j] = T[(k8 + j) * 65 + n];
        u32x4 w; w.x = cvt_pk_bf16(x[0], x[1]); w.y = cvt_pk_bf16(x[2], x[3]); w.z = cvt_pk_bf16(x[4], x[5]); w.w = cvt_pk_bf16(x[6], x[7]);
        *(u32x4*)(dst + (size_t)n * ld_dst + k8) = w; }
    asm volatile("s_waitcnt lgkmcnt(0)" ::: "memory"); __builtin_amdgcn_wave_barrier();
}

__device__ __forceinline__ void phase_prologue(Ctx c) {
    { int t_ = TID_NOW(c.wave); asm volatile("" : "+v"(t_)); c.tid = t_; c.lane = t_ & 63; }
    bf16_t* WinT = (bf16_t*)(c.ws + WS_WINT); bf16_t* WoutT = (bf16_t*)(c.ws + WS_WOUTT); bf16_t* GluT = (bf16_t*)(c.ws + WS_GLUT);
    const int nWin = 2 * 16 * 44, nWout = 2 * 16 * 16, nGlu = 2 * 4 * 4;
    if (c.wg >= 192)
    for (int it = (c.wg - 192) * 8 + c.wave; it < nWin + nWout + nGlu; it += (c.G - 192) * 8) {
        if (it < nWin) { const int l = it / (16 * 44), r = it % (16 * 44), kt = r / 44, ntl = r % 44;
            transpose_tile(c, c.in[8] + (size_t)l * DM * PW + (size_t)kt * 64 * PW + ntl * 64, PW, WinT + (size_t)l * PW * DM + (size_t)ntl * 64 * DM + kt * 64, DM); }
        else if (it < nWin + nWout) { const int j = it - nWin, l = j / 256, r = j % 256, kt = r / 16, ntl = r % 16;
            transpose_tile(c, c.in[9] + (size_t)l * DM * DM + (size_t)kt * 64 * DM + ntl * 64, DM, WoutT + (size_t)l * DM * DM + (size_t)ntl * 64 * DM + kt * 64, DM); }
        else { const int j = it - nWin - nWout, l = j / 16, r = j % 16, kt = r / 4, ntl = r % 4;
            transpose_tile(c, c.in[22] + (size_t)l * 65536 + (size_t)kt * 64 * 256 + ntl * 64, 256, GluT + (size_t)l * 65536 + (size_t)ntl * 64 * 256 + kt * 64, 256); }
    }
    __syncthreads();
    float* modv = (float*)(c.ws + WS_MODV);
    LAS float* red = (LAS float*)c.lds;
    const int fr = c.lane & 15, kq = c.lane >> 4;
    for (int it = c.wg; it < 192; it += c.G) {
        const int l = it / 96, col0 = (it % 96) * 64;
        f32x4 acc[4][3];
#pragma unroll
        for (int ct = 0; ct < 4; ++ct)
#pragma unroll
            for (int rt = 0; rt < 3; ++rt) acc[ct][rt] = (f32x4){0.f, 0.f, 0.f, 0.f};
        const float* wp = c.in[4] + (size_t)l * DM * 6144 + (size_t)(c.wave * 128 + kq) * 6144 + col0 + fr;
        const float* cp0 = c.in[1] + (size_t)fr * DM + c.wave * 128 + kq;
        const float* cp1 = cp0 + (size_t)16 * DM;
        const float* cp2 = c.in[3] + c.wave * 128 + kq;
#pragma unroll 8
        for (int s = 0; s < 32; ++s) {
            float a[4];
#pragma unroll
            for (int ct = 0; ct < 4; ++ct) a[ct] = wp[(size_t)(4 * s) * 6144 + 16 * ct];
            const float b0 = siluf_(cp0[4 * s]), b1 = siluf_(cp1[4 * s]);
            float b2 = 0.f; if (fr == 0) b2 = siluf_(cp2[4 * s]);
#pragma unroll
            for (int ct = 0; ct < 4; ++ct) {
                acc[ct][0] = __builtin_amdgcn_mfma_f32_16x16x4f32(a[ct], b0, acc[ct][0], 0, 0, 0);
                acc[ct][1] = __builtin_amdgcn_mfma_f32_16x16x4f32(a[ct], b1, acc[ct][1], 0, 0, 0);
                acc[ct][2] = __builtin_amdgcn_mfma_f32_16x16x4f32(a[ct], b2, acc[ct][2], 0, 0, 0); }
        }
        __syncthreads();
#pragma unroll
        for (int ct = 0; ct < 4; ++ct)
#pragma unroll
            for (int rt = 0; rt < 3; ++rt)
#pragma unroll
                for (int rr = 0; rr < 4; ++rr) red[(c.wave * 48 + (ct * 3 + rt) * 4 + rr) * 64 + c.lane] = acc[ct][rt][rr];
        __syncthreads();
        for (int i = c.tid; i < 48 * 64; i += NTHR) { const int idx = i >> 6, ln = i & 63, ct = idx / 12, rt = (idx % 12) >> 2, rr = idx & 3;
            const int r = 16 * rt + (ln & 15), col = col0 + 16 * ct + 4 * (ln >> 4) + rr;
            float v = 0.f;
#pragma unroll
            for (int w = 0; w < 8; ++w) v += red[(w * 48 + idx) * 64 + ln];
            if (r < 33) modv[((size_t)l * 33 + r) * 6144 + col] = v + c.in[5][(size_t)l * 6144 + col]; }
        __syncthreads();
    }
}

__device__ __forceinline__ void phase_norm1_l0(Ctx c, int l) {
    { int t_ = TID_NOW(c.wave); asm volatile("" : "+v"(t_)); c.tid = t_; c.lane = t_ & 63; }
    const float* modv = (const float*)(c.ws + WS_MODV) + (size_t)l * 33 * 6144;
    const float* modp = (const float*)(c.ws + WS_MODV) + 5 * 1024;
    const float* nw = c.in[6] + (size_t)l * DM;
    bf16_t* H = (bf16_t*)(c.ws + WS_H);
    bf16_t* xw = (bf16_t*)(c.ws + WS_X);
    const bf16_t* Y = (const bf16_t*)(c.ws + WS_MIX); const bf16_t* Y1 = (const bf16_t*)(c.ws + WS_H);
    f32x4 wv[4];
#pragma unroll
    for (int k = 0; k < 4; ++k) wv[k] = *(const f32x4*)(nw + (k >> 1) * 512 + c.lane * 8 + (k & 1) * 4);
    const int nw8 = c.G * 8;
#define N1_UNPK(PK_, lo4, hi4) do { const u32x4 pk_ = (PK_); lo4 = (f32x4){lo_bf(pk_.x), hi_bf(pk_.x), lo_bf(pk_.y), hi_bf(pk_.y)}; hi4 = (f32x4){lo_bf(pk_.z), hi_bf(pk_.z), lo_bf(pk_.w), hi_bf(pk_.w)}; } while (0)
    for (int row = c.wg * 8 + c.wave; row < TALL; row += 2 * nw8) {
        const int rowb = row + nw8; const bool hb = rowb < TALL; const int rb2 = hb ? rowb : row;
        f32x4 va[4], vb[4];
        if (l == 0) {
            const float* xa = row < TLAT ? c.in[0] + (size_t)row * DM : c.in[2] + (size_t)(row - TLAT) * DM;
            const float* xb = rb2 < TLAT ? c.in[0] + (size_t)rb2 * DM : c.in[2] + (size_t)(rb2 - TLAT) * DM;
#pragma unroll
            for (int k = 0; k < 4; ++k) { const int cc = (k >> 1) * 512 + c.lane * 8 + (k & 1) * 4; va[k] = *(const f32x4*)(xa + cc); vb[k] = *(const f32x4*)(xb + cc); }
        } else {
            const float* ga = modp + (size_t)mod_row(row) * 6144; const float* gb = modp + (size_t)mod_row(rb2) * 6144;
            u32x4 xa[2], xb[2], ya[2], yb[2], za[2], zb[2];
#pragma unroll
            for (int j = 0; j < 2; ++j) { const int cc = j * 512 + c.lane * 8;
                xa[j] = *(const u32x4*)(xw + (size_t)row * DM + cc); xb[j] = *(const u32x4*)(xw + (size_t)rb2 * DM + cc);
                ya[j] = *(const u32x4*)(Y + (size_t)row * DM + cc); yb[j] = *(const u32x4*)(Y + (size_t)rb2 * DM + cc);
                za[j] = *(const u32x4*)(Y1 + (size_t)row * DM + cc); zb[j] = *(const u32x4*)(Y1 + (size_t)rb2 * DM + cc); }
#pragma unroll
            for (int j = 0; j < 2; ++j) { const int cc = j * 512 + c.lane * 8;
                f32x4 x0, x1, y0, y1, z0, z1;
                N1_UNPK(xa[j], x0, x1); N1_UNPK(ya[j], y0, y1); N1_UNPK(za[j], z0, z1);
                va[2 * j] = x0 + *(const f32x4*)(ga + cc) * (y0 + z0); va[2 * j + 1] = x1 + *(const f32x4*)(ga + cc + 4) * (y1 + z1);
                N1_UNPK(xb[j], x0, x1); N1_UNPK(yb[j], y0, y1); N1_UNPK(zb[j], z0, z1);
                vb[2 * j] = x0 + *(const f32x4*)(gb + cc) * (y0 + z0); vb[2 * j + 1] = x1 + *(const f32x4*)(gb + cc + 4) * (y1 + z1); }
        }
#pragma unroll
        for (int j = 0; j < 2; ++j) { const int cc = j * 512 + c.lane * 8;
            u32x4 oa; oa.x = cvt_pk_bf16(va[2 * j][0], va[2 * j][1]); oa.y = cvt_pk_bf16(va[2 * j][2], va[2 * j][3]); oa.z = cvt_pk_bf16(va[2 * j + 1][0], va[2 * j + 1][1]); oa.w = cvt_pk_bf16(va[2 * j + 1][2], va[2 * j + 1][3]);
            *(u32x4*)(xw + (size_t)row * DM + cc) = oa;
            if (hb) { u32x4 ob; ob.x = cvt_pk_bf16(vb[2 * j][0], vb[2 * j][1]); ob.y = cvt_pk_bf16(vb[2 * j][2], vb[2 * j][3]); ob.z = cvt_pk_bf16(vb[2 * j + 1][0], vb[2 * j + 1][1]); ob.w = cvt_pk_bf16(vb[2 * j + 1][2], vb[2 * j + 1][3]);
                *(u32x4*)(xw + (size_t)rowb * DM + cc) = ob; } }
        const float* mpa = modv + (size_t)mod_row(row) * 6144; const float* mpb = modv + (size_t)mod_row(rb2) * 6144;
        f32x4 sha[4], sca[4], shb[4], scb[4];
#pragma unroll
        for (int k = 0; k < 4; ++k) { const int cc = (k >> 1) * 512 + c.lane * 8 + (k & 1) * 4; sha[k] = *(const f32x4*)(mpa + cc); sca[k] = *(const f32x4*)(mpa + 1024 + cc); shb[k] = *(const f32x4*)(mpb + cc); scb[k] = *(const f32x4*)(mpb + 1024 + cc); }
        float sa = 0.f, sb = 0.f;
#pragma unroll
        for (int k = 0; k < 4; ++k) { sa += va[k][0] * va[k][0] + va[k][1] * va[k][1] + va[k][2] * va[k][2] + va[k][3] * va[k][3]; sb += vb[k][0] * vb[k][0] + vb[k][1] * vb[k][1] + vb[k][2] * vb[k][2] + vb[k][3] * vb[k][3]; }
        sa = wave_sum(sa); sb = wave_sum(sb);
        const float ra = rsqrtf(sa * (1.0f / DM) + NORM_EPS), rb = rsqrtf(sb * (1.0f / DM) + NORM_EPS);
#pragma unroll
        for (int j = 0; j < 2; ++j) { const int cc = j * 512 + c.lane * 8;
            const f32x4 ya0 = (va[2 * j] * ra * wv[2 * j]) * (sca[2 * j] + 1.0f) + sha[2 * j], ya1 = (va[2 * j + 1] * ra * wv[2 * j + 1]) * (sca[2 * j + 1] + 1.0f) + sha[2 * j + 1];
            u32x4 o; o.x = cvt_pk_bf16(ya0[0], ya0[1]); o.y = cvt_pk_bf16(ya0[2], ya0[3]); o.z = cvt_pk_bf16(ya1[0], ya1[1]); o.w = cvt_pk_bf16(ya1[2], ya1[3]);
            *(u32x4*)(H + (size_t)row * DM + cc) = o;
            if (hb) { const f32x4 yb0 = (vb[2 * j] * rb * wv[2 * j]) * (scb[2 * j] + 1.0f) + shb[2 * j], yb1 = (vb[2 * j + 1] * rb * wv[2 * j + 1]) * (scb[2 * j + 1] + 1.0f) + shb[2 * j + 1];
                u32x4 o2; o2.x = cvt_pk_bf16(yb0[0], yb0[1]); o2.y = cvt_pk_bf16(yb0[2], yb0[3]); o2.z = cvt_pk_bf16(yb1[0], yb1[1]); o2.w = cvt_pk_bf16(yb1[2], yb1[3]);
                *(u32x4*)(H + (size_t)rowb * DM + cc) = o2; } }
    }
#undef N1_UNPK
}

__device__ __forceinline__ void phase_norm1_l1(Ctx c, int l) {
    { int t_ = TID_NOW(c.wave); asm volatile("" : "+v"(t_)); c.tid = t_; c.lane = t_ & 63; }
    const float* modv = (const float*)(c.ws + WS_MODV) + (size_t)l * 33 * 6144;
    const float* modp = (const float*)(c.ws + WS_MODV) + 5 * 1024;
    const float* nw = c.in[6] + (size_t)l * DM;
    bf16_t* H = (bf16_t*)(c.ws + WS_H);
    bf16_t* xw = (bf16_t*)(c.ws + WS_X);
    const bf16_t* Y = (const bf16_t*)(c.ws + WS_MIX); const bf16_t* Y1 = (const bf16_t*)(c.ws + WS_H);
    constexpr int NR = 4;
    f32x4 wv[4];
#pragma unroll
    for (int k = 0; k < 4; ++k) wv[k] = *(const f32x4*)(nw + (k >> 1) * 512 + c.lane * 8 + (k & 1) * 4);
    const int nw8 = c.G * 8;
#define N1_UNPK(PK_, lo4, hi4) do { const u32x4 pk_ = (PK_); lo4 = (f32x4){lo_bf(pk_.x), hi_bf(pk_.x), lo_bf(pk_.y), hi_bf(pk_.y)}; hi4 = (f32x4){lo_bf(pk_.z), hi_bf(pk_.z), lo_bf(pk_.w), hi_bf(pk_.w)}; } while (0)
    for (int row0 = (c.wg * 8 + c.wave) * NR; row0 < TALL; row0 += nw8 * NR) {
        f32x4 v[NR][4];
        const int mr = mod_row(row0);
        if (l == 0) {
            const float* xs = row0 < TLAT ? c.in[0] + (size_t)row0 * DM : c.in[2] + (size_t)(row0 - TLAT) * DM;
#pragma unroll
            for (int q = 0; q < NR; ++q)
#pragma unroll
                for (int k = 0; k < 4; ++k) v[q][k] = *(const f32x4*)(xs + (size_t)q * DM + (k >> 1) * 512 + c.lane * 8 + (k & 1) * 4);
        } else {
            const float* ga = modp + (size_t)mr * 6144;
            u32x4 xa[NR][2], ya[NR][2], za[NR][2];
#pragma unroll
            for (int q = 0; q < NR; ++q)
#pragma unroll
                for (int j = 0; j < 2; ++j) { const size_t o = (size_t)(row0 + q) * DM + j * 512 + c.lane * 8; xa[q][j] = *(const u32x4*)(xw + o); ya[q][j] = *(const u32x4*)(Y + o); za[q][j] = *(const u32x4*)(Y1 + o); }
            f32x4 gt[4];
#pragma unroll
            for (int k = 0; k < 4; ++k) gt[k] = *(const f32x4*)(ga + (k >> 1) * 512 + c.lane * 8 + (k & 1) * 4);
#pragma unroll
            for (int q = 0; q < NR; ++q)
#pragma unroll
                for (int j = 0; j < 2; ++j) { f32x4 x0, x1, y0, y1, z0, z1;
                    N1_UNPK(xa[q][j], x0, x1); N1_UNPK(ya[q][j], y0, y1); N1_UNPK(za[q][j], z0, z1);
                    v[q][2 * j] = x0 + gt[2 * j] * (y0 + z0); v[q][2 * j + 1] = x1 + gt[2 * j + 1] * (y1 + z1); }
        }
#pragma unroll
        for (int q = 0; q < NR; ++q)
#pragma unroll
            for (int j = 0; j < 2; ++j) {
                u32x4 oa; oa.x = cvt_pk_bf16(v[q][2 * j][0], v[q][2 * j][1]); oa.y = cvt_pk_bf16(v[q][2 * j][2], v[q][2 * j][3]); oa.z = cvt_pk_bf16(v[q][2 * j + 1][0], v[q][2 * j + 1][1]); oa.w = cvt_pk_bf16(v[q][2 * j + 1][2], v[q][2 * j + 1][3]);
                *(u32x4*)(xw + (size_t)(row0 + q) * DM + j * 512 + c.lane * 8) = oa; }
        const float* mp = modv + (size_t)mr * 6144;
        f32x4 sh[4], sc[4];
#pragma unroll
        for (int k = 0; k < 4; ++k) { const int cc = (k >> 1) * 512 + c.lane * 8 + (k & 1) * 4; sh[k] = *(const f32x4*)(mp + cc); sc[k] = (*(const f32x4*)(mp + 1024 + cc) + 1.0f) * wv[k]; }
#pragma unroll
        for (int q = 0; q < NR; ++q) {
            float ss = 0.f;
#pragma unroll
            for (int k = 0; k < 4; ++k) ss += (v[q][k][0] * v[q][k][0] + v[q][k][1] * v[q][k][1]) + (v[q][k][2] * v[q][k][2] + v[q][k][3] * v[q][k][3]);
            ss = wave_sum(ss);
            const float rs = rsqrtf(ss * (1.0f / DM) + NORM_EPS);
#pragma unroll
            for (int j = 0; j < 2; ++j) {
                const f32x4 y0 = (v[q][2 * j] * rs) * sc[2 * j] + sh[2 * j], y1 = (v[q][2 * j + 1] * rs) * sc[2 * j + 1] + sh[2 * j + 1];
                u32x4 o; o.x = cvt_pk_bf16(y0[0], y0[1]); o.y = cvt_pk_bf16(y0[2], y0[3]); o.z = cvt_pk_bf16(y1[0], y1[1]); o.w = cvt_pk_bf16(y1[2], y1[3]);
                *(u32x4*)(H + (size_t)(row0 + q) * DM + j * 512 + c.lane * 8) = o; } }
    }
#undef N1_UNPK
}

__device__ __forceinline__ int scan_row(int b, int dir, int si) {
    if (si < CTXL) return TLAT + b * CTXL + (dir ? (CTXL - 1 - si) : si);
    const int tt = si - CTXL; return b * SEQL + (dir ? (SEQL - 1 - tt) : tt);
}
__device__ __forceinline__ unsigned pack_bf2(float a, float b) { return cvt_pk_bf16(a, b); }
__device__ __forceinline__ void phase_hgrn(Ctx c, int l) {
    { int t_ = TID_NOW(c.wave); asm volatile("" : "+v"(t_)); c.tid = t_; c.lane = t_ & 63; }
    const bf16_t* P = (const bf16_t*)(c.ws + WS_P);
    bf16_t* S = (bf16_t*)(c.ws + WS_H);
    constexpr int RS = 72;
    LAS bf16_t* QD = (LAS bf16_t*)c.lds;
    LAS bf16_t* QP = QD + 64 * RS;
    LAS bf16_t* KI = QP + 64 * RS;
    LAS bf16_t* KT = KI + 160 * RS;
    LAS bf16_t* VT = KT + 64 * RS;
    LAS bf16_t* AT = VT + 64 * RS;
    LAS bf16_t* ST = AT + 64 * RS;
    LAS float* TOT = (LAS float*)(ST + 2 * 64 * RS);
    LAS float* DV = TOT + 512;
    const int w = c.wave, lane = c.lane, fr = lane & 15, g = lane >> 4;
    const int ib = w >> 1, vtl = w & 3, th = w >> 2;
    constexpr int NCH = (CTXL + SEQL) / 64;
    for (int it = c.wg; it < NBATCH * 4 * 2; it += c.G) {
        const int dir = it & 1, hd = (it >> 1) & 3, b = it >> 3;
        const int fcol = (dir ? C_CFB : C_CFF) + hd * 64 + lane, qcol = C_CQ + hd * 64 + lane, icol = C_CI + hd * 64 + lane;
        float lb = 0.f;
        if (l == 1) { const float a0 = c.in[12][(size_t)(dir * 2 + 0) * 256 + hd * 64 + lane], a1 = c.in[12][(size_t)(dir * 2 + 1) * 256 + hd * 64 + lane]; lb = 1.0f / (1.0f + __expf(a0 - a1)); }
        __syncthreads();
        for (int i = c.tid; i < 64 * RS / 2; i += NTHR) { ((LAS unsigned*)AT)[i] = 0u; ((LAS unsigned*)ST)[i] = 0u; }
        f32x4 sacc[2]; sacc[0] = (f32x4){0.f, 0.f, 0.f, 0.f}; sacc[1] = (f32x4){0.f, 0.f, 0.f, 0.f};
        int cur = 0;
        unsigned short rq[8], rf[8], ri[8];
#pragma unroll
        for (int j = 0; j < 8; ++j) { const bf16_t* pr = P + (size_t)scan_row(b, dir, 8 * w + j) * PW; rq[j] = pr[qcol]; rf[j] = pr[fcol]; ri[j] = pr[icol]; }
        for (int ch = 0; ch < NCH; ++ch) {
            const int seq0 = ch * 64;
            float qa[8], kk[8], cs[8]; float run = 0.f;
#pragma unroll
            for (int j = 0; j < 8; ++j) { const float x = bf2f(rf[j]), q = bf2f(rq[j]);
                const float rinv = __builtin_amdgcn_rcpf(1.0f + __builtin_amdgcn_exp2f(-1.4426950408889634f * x));
                const float f = lb + (1.0f - lb) * rinv; kk[j] = 1.0f - f; run += __builtin_amdgcn_logf(fmaxf(f, 1e-30f)); cs[j] = run;
                qa[j] = q * __builtin_amdgcn_rcpf(1.0f + __builtin_amdgcn_exp2f(-1.4426950408889634f * q)); }
            TOT[w * 64 + lane] = run;
            __syncthreads();
            float T8[8];
#pragma unroll
            for (int t = 0; t < 8; ++t) T8[t] = TOT[t * 64 + lane];
            const float r1 = T8[0] + T8[1], r2 = r1 + T8[2] + T8[3], r3 = r2 + T8[4] + T8[5], bend = r3 + T8[6] + T8[7];
            float off = 0.f;
#pragma unroll
            for (int t = 0; t < 8; ++t) off += (t < w) ? T8[t] : 0.f;
            const float r0o = ib == 0 ? 0.f : (ib == 1 ? r1 : (ib == 2 ? r2 : r3));
            const float rnx = ib == 0 ? r1 : (ib == 1 ? r2 : (ib == 2 ? r3 : bend));
            const float c0 = __builtin_amdgcn_exp2f(r0o), ct = __builtin_amdgcn_exp2f(bend - rnx);
            const float c1 = __builtin_amdgcn_exp2f(r1 - rnx), c2 = __builtin_amdgcn_exp2f(r2 - rnx), c3 = __builtin_amdgcn_exp2f(r3 - rnx);
            const int kdo = ib == 0 ? 0 : (ib == 1 ? 16 : (ib == 2 ? 48 : 96));
            float ktv[8];
#pragma unroll
            for (int j = 0; j < 8; ++j) { const int tau = 8 * w + j; const float bb = off + cs[j];
                const float qd = qa[j] * __builtin_amdgcn_exp2f(bb - r0o);
                QD[tau * RS + lane] = f2bf(qd);
                QP[tau * RS + lane] = f2bf(qd * c0);
                KI[(kdo + tau) * RS + lane] = f2bf(kk[j] * __builtin_amdgcn_exp2f(fminf(r0o - bb, 86.0f)));
                const float ke = kk[j] * __builtin_amdgcn_exp2f(rnx - bb);
                if (ib < 1) KI[(16 + tau) * RS + lane] = f2bf(ke * c1);
                if (ib < 2) KI[(48 + tau) * RS + lane] = f2bf(ke * c2);
                if (ib < 3) KI[(96 + tau) * RS + lane] = f2bf(ke * c3);
                ktv[j] = ke * ct; }
            { u32x4 wk, wv; wk.x = pack_bf2(ktv[0], ktv[1]); wk.y = pack_bf2(ktv[2], ktv[3]); wk.z = pack_bf2(ktv[4], ktv[5]); wk.w = pack_bf2(ktv[6], ktv[7]);
              wv.x = (unsigned)ri[0] | ((unsigned)ri[1] << 16); wv.y = (unsigned)ri[2] | ((unsigned)ri[3] << 16); wv.z = (unsigned)ri[4] | ((unsigned)ri[5] << 16); wv.w = (unsigned)ri[6] | ((unsigned)ri[7] << 16);
              *(LAS u32x4*)(KT + lane * RS + 8 * w) = wk; *(LAS u32x4*)(VT + lane * RS + 8 * w) = wv; }
            if (w == 0) DV[lane] = __builtin_amdgcn_exp2f(bend);
            __syncthreads();
            if (ch + 1 < NCH) {
#pragma unroll
                for (int j = 0; j < 8; ++j) { const bf16_t* pr = P + (size_t)scan_row(b, dir, seq0 + 64 + 8 * w + j) * PW; rq[j] = pr[qcol]; rf[j] = pr[fcol]; ri[j] = pr[icol]; }
            }
            const bool need_o = !(l == 1 && seq0 < CTXL);
            if (need_o) {
                for (int idx = w; idx < 10; idx += 8) {
                    const int i = idx < 1 ? 0 : (idx < 3 ? 1 : (idx < 6 ? 2 : 3)), j = idx - ((i * (i + 1)) >> 1);
                    const int koff = i == 0 ? 0 : (i == 1 ? 16 : (i == 2 ? 48 : 96));
                    const LAS bf16_t* ap = KI + (koff + 16 * j + fr) * RS + g * 8; const LAS bf16_t* bp = QD + (16 * i + fr) * RS + g * 8;
                    f32x4 cc = (f32x4){0.f, 0.f, 0.f, 0.f};
                    cc = __builtin_amdgcn_mfma_f32_16x16x32_bf16(*(const LAS bf16x8*)ap, *(const LAS bf16x8*)bp, cc, 0, 0, 0);
                    cc = __builtin_amdgcn_mfma_f32_16x16x32_bf16(*(const LAS bf16x8*)(ap + 32), *(const LAS bf16x8*)(bp + 32), cc, 0, 0, 0);
                    if (j == i) {
#pragma unroll
                        for (int r = 0; r < 4; ++r) if (g * 4 + r > fr) cc[r] = 0.f; }
                    u32x2 o; o.x = pack_bf2(cc[0], cc[1]); o.y = pack_bf2(cc[2], cc[3]);
                    *(LAS u32x2*)(AT + (16 * i + fr) * RS + 16 * j + g * 4) = o;
                }
            }
            __syncthreads();
            if (need_o) {
#pragma unroll
                for (int ii = 0; ii < 2; ++ii) { const int i = 2 * th + ii;
                    f32x4 acc = (f32x4){0.f, 0.f, 0.f, 0.f};
                    const LAS bf16_t* sp = ST + cur * 64 * RS + (16 * vtl + fr) * RS + g * 8; const LAS bf16_t* qp = QP + (16 * i + fr) * RS + g * 8;
                    acc = __builtin_amdgcn_mfma_f32_16x16x32_bf16(*(const LAS bf16x8*)sp, *(const LAS bf16x8*)qp, acc, 0, 0, 0);
                    acc = __builtin_amdgcn_mfma_f32_16x16x32_bf16(*(const LAS bf16x8*)(sp + 32), *(const LAS bf16x8*)(qp + 32), acc, 0, 0, 0);
                    const LAS bf16_t* vp = VT + (16 * vtl + fr) * RS + g * 8; const LAS bf16_t* ap = AT + (16 * i + fr) * RS + g * 8;
                    acc = __builtin_amdgcn_mfma_f32_16x16x32_bf16(*(const LAS bf16x8*)vp, *(const LAS bf16x8*)ap, acc, 0, 0, 0);
                    if (i >= 2) acc = __builtin_amdgcn_mfma_f32_16x16x32_bf16(*(const LAS bf16x8*)(vp + 32), *(const LAS bf16x8*)(ap + 32), acc, 0, 0, 0);
                    const int row = scan_row(b, dir, seq0 + 16 * i + fr);
                    u32x2 o; o.x = pack_bf2(acc[0], acc[1]); o.y = pack_bf2(acc[2], acc[3]);
                    *(u32x2*)(S + (size_t)dir * SPART + (size_t)row * 256 + hd * 64 + 16 * vtl + g * 4) = o; }
            }
#pragma unroll
            for (int k2 = 0; k2 < 2; ++k2) { const int kt = 2 * th + k2; const float d = DV[16 * kt + fr];
                sacc[k2] *= d;
                const LAS bf16_t* vp = VT + (16 * vtl + fr) * RS + g * 8; const LAS bf16_t* kp = KT + (16 * kt + fr) * RS + g * 8;
                sacc[k2] = __builtin_amdgcn_mfma_f32_16x16x32_bf16(*(const LAS bf16x8*)vp, *(const LAS bf16x8*)kp, sacc[k2], 0, 0, 0);
                sacc[k2] = __builtin_amdgcn_mfma_f32_16x16x32_bf16(*(const LAS bf16x8*)(vp + 32), *(const LAS bf16x8*)(kp + 32), sacc[k2], 0, 0, 0);
                LAS bf16_t* sn = ST + (cur ^ 1) * 64 * RS + (16 * vtl + g * 4) * RS + 16 * kt + fr;
#pragma unroll
                for (int r = 0; r < 4; ++r) sn[r * RS] = f2bf(sacc[k2][r]); }
            cur ^= 1;
        }
    }
}

typedef short bf16x4 __attribute__((ext_vector_type(4)));
__device__ __forceinline__ void phase_s5(Ctx c, int l) {
    { int t_ = TID_NOW(c.wave); asm volatile("" : "+v"(t_)); c.tid = t_; c.lane = t_ & 63; }
    const bf16_t* P = (const bf16_t*)(c.ws + WS_P);
    bf16_t* S = (bf16_t*)(c.ws + WS_H) + 2 * SPART;
    constexpr int CH = 32, BS = 132, XS = 136;
    LAS float* BU = (LAS float*)(c.lds + c.wave * 25600);
    LAS bf16_t* X = (LAS bf16_t*)(c.lds + c.wave * 25600 + CH * BS * 4);
    const int lane = c.lane, fr = lane & 15, g4 = lane >> 4;
    for (int it = c.wg * 4 + c.wave; it < NBATCH * 16 * 2; it += c.G * 4) {
        const int dir = it & 1, grp = (it >> 1) & 15, b = it >> 5;
        const size_t gbase = ((size_t)(l * 2 + dir) * 16 + grp) * 64;
        const float dt = expf(c.in[16][(size_t)(l * 2 + dir) * 16 + grp]);
        float ar, ai;
        { const float lr = c.in[14][gbase + lane], li = c.in[15][gbase + lane]; const float mag = expf(lr * dt); float sn, cs; sincosf(li * dt, &sn, &cs); ar = mag * cs; ai = mag * sn; }
        bf16x4 bh[8], bl[8];
#pragma unroll
        for (int nt = 0; nt < 4; ++nt) { const size_t pi = gbase + nt * 16 + fr;
            const float lr = c.in[14][pi], li = c.in[15][pi]; const float mag = expf(lr * dt); float sn, cs; sincosf(li * dt, &sn, &cs);
            const float pr = mag * cs, pim = mag * sn, den = lr * lr + li * li;
            const float kr = ((pr - 1.0f) * lr + pim * li) / den, ki = (pim * lr - (pr - 1.0f) * li) / den;
            const f32x4 br = *(const f32x4*)(c.in[17] + pi * 16 + g4 * 4), bi = *(const f32x4*)(c.in[18] + pi * 16 + g4 * 4);
            const f32x4 vr = kr * br - ki * bi, vi = kr * bi + ki * br;
            u32x2 h, lo2;
            h.x = cvt_pk_bf16(vr[0], vr[1]); h.y = cvt_pk_bf16(vr[2], vr[3]);
            lo2.x = cvt_pk_bf16(vr[0] - lo_bf(h.x), vr[1] - hi_bf(h.x)); lo2.y = cvt_pk_bf16(vr[2] - lo_bf(h.y), vr[3] - hi_bf(h.y));
            bh[nt] = __builtin_bit_cast(bf16x4, h); bl[nt] = __builtin_bit_cast(bf16x4, lo2);
            h.x = cvt_pk_bf16(vi[0], vi[1]); h.y = cvt_pk_bf16(vi[2], vi[3]);
            lo2.x = cvt_pk_bf16(vi[0] - lo_bf(h.x), vi[1] - hi_bf(h.x)); lo2.y = cvt_pk_bf16(vi[2] - lo_bf(h.y), vi[3] - hi_bf(h.y));
            bh[4 + nt] = __builtin_bit_cast(bf16x4, h); bl[4 + nt] = __builtin_bit_cast(bf16x4, lo2); }
        bf16x8 cf[4];
#pragma unroll
        for (int ks = 0; ks < 4; ++ks) { const int kap = ks * 32 + g4 * 8; const bool im = kap >= 64; const float* cp = (im ? c.in[20] : c.in[19]) + (((size_t)(l * 2 + dir) * 16 + grp) * 16 + fr) * 64 + (kap & 63);
            const f32x4 a = *(const f32x4*)cp, bq = *(const f32x4*)(cp + 4); const float sg = im ? -1.f : 1.f;
            u32x4 w; w.x = cvt_pk_bf16(sg * a[0], sg * a[1]); w.y = cvt_pk_bf16(sg * a[2], sg * a[3]); w.z = cvt_pk_bf16(sg * bq[0], sg * bq[1]); w.w = cvt_pk_bf16(sg * bq[2], sg * bq[3]);
            cf[ks] = __builtin_bit_cast(bf16x8, w); }
        float xr = 0.f, xi = 0.f;
        u32x2 un[2];
#pragma unroll
        for (int mt = 0; mt < 2; ++mt) un[mt] = *(const u32x2*)(P + (size_t)scan_row(b, dir, mt * 16 + fr) * PW + C_DU + grp * 16 + g4 * 4);
        constexpr int NCH = (CTXL + SEQL) / CH;
        for (int ch = 0; ch < NCH; ++ch) {
            const bf16x4 ua0 = __builtin_bit_cast(bf16x4, un[0]), ua1 = __builtin_bit_cast(bf16x4, un[1]);
            if (ch + 1 < NCH) {
#pragma unroll
                for (int mt = 0; mt < 2; ++mt) un[mt] = *(const u32x2*)(P + (size_t)scan_row(b, dir, (ch + 1) * CH + mt * 16 + fr) * PW + C_DU + grp * 16 + g4 * 4); }
#pragma unroll
            for (int nt = 0; nt < 8; ++nt) {
                f32x4 t0 = (f32x4){0.f, 0.f, 0.f, 0.f}, t1 = (f32x4){0.f, 0.f, 0.f, 0.f};
                t0 = __builtin_amdgcn_mfma_f32_16x16x16bf16_1k(ua0, bh[nt], t0, 0, 0, 0); t0 = __builtin_amdgcn_mfma_f32_16x16x16bf16_1k(ua0, bl[nt], t0, 0, 0, 0);
                t1 = __builtin_amdgcn_mfma_f32_16x16x16bf16_1k(ua1, bh[nt], t1, 0, 0, 0); t1 = __builtin_amdgcn_mfma_f32_16x16x16bf16_1k(ua1, bl[nt], t1, 0, 0, 0);
#pragma unroll
                for (int r = 0; r < 4; ++r) { BU[(g4 * 4 + r) * BS + nt * 16 + fr] = t0[r]; BU[(16 + g4 * 4 + r) * BS + nt * 16 + fr] = t1[r]; }
            }
            asm volatile("s_waitcnt lgkmcnt(0)" ::: "memory"); __builtin_amdgcn_wave_barrier();
            float br_[CH], bi_[CH];
#pragma unroll
            for (int t = 0; t < CH; ++t) { br_[t] = BU[t * BS + lane]; bi_[t] = BU[t * BS + 64 + lane]; }
#pragma unroll
            for (int t = 0; t < CH; ++t) { const float nr = ar * xr - ai * xi + br_[t], ni = ar * xi + ai * xr + bi_[t]; xr = nr; xi = ni;
                X[t * XS + lane] = f2bf(xr); X[t * XS + 64 + lane] = f2bf(xi); }
            asm volatile("s_waitcnt lgkmcnt(0)" ::: "memory"); __builtin_amdgcn_wave_barrier();
            if (!(l == 1 && ch * CH < CTXL)) {
#pragma unroll
                for (int tt = 0; tt < 2; ++tt) { f32x4 y = (f32x4){0.f, 0.f, 0.f, 0.f};
#pragma unroll
                    for (int ks = 0; ks < 4; ++ks) { const bf16x8 xf = *(const LAS bf16x8*)(X + (tt * 16 + fr) * XS + ks * 32 + g4 * 8); y = __builtin_amdgcn_mfma_f32_16x16x32_bf16(cf[ks], xf, y, 0, 0, 0); }
                    const int row2 = scan_row(b, dir, ch * CH + tt * 16 + fr);
                    u32x2 o; o.x = cvt_pk_bf16(y[0], y[1]); o.y = cvt_pk_bf16(y[2], y[3]);
                    *(u32x2*)(S + (size_t)dir * SPART + (size_t)row2 * 256 + grp * 16 + g4 * 4) = o; }
            }
            asm volatile("s_waitcnt lgkmcnt(0)" ::: "memory"); __builtin_amdgcn_wave_barrier();
        }
    }
}

struct KFrag { bf16x8 k00, k01, k10, k11; };
struct VFrag { bf16x8 v0, v1, v2, v3; };
__device__ __forceinline__ void k_load(KFrag& f, const bf16_t* P, unsigned k0, unsigned k1) {
    const char* Pb = (const char*)P;
    f.k00 = *(const bf16x8*)(Pb + (size_t)(k0 * 2u)); f.k01 = *(const bf16x8*)(Pb + (size_t)(k0 * 2u + 64u)); f.k10 = *(const bf16x8*)(Pb + (size_t)(k1 * 2u)); f.k11 = *(const bf16x8*)(Pb + (size_t)(k1 * 2u + 64u));
}
__device__ __forceinline__ void v_load(VFrag& f, const bf16_t* P, unsigned v) {
    const char* Pb = (const char*)P;
    f.v0 = *(const bf16x8*)(Pb + (size_t)(v * 2u)); f.v1 = *(const bf16x8*)(Pb + (size_t)(v * 2u + 16u * PW * 2u)); f.v2 = *(const bf16x8*)(Pb + (size_t)(v * 2u + 32u * PW * 2u)); f.v3 = *(const bf16x8*)(Pb + (size_t)(v * 2u + 48u * PW * 2u));
}
__device__ __forceinline__ void attn_qk(const KFrag& f, bf16x8 q0, bf16x8 q1, f32x4 negm, f32x4& s0, f32x4& s1) {
    s0 = __builtin_amdgcn_mfma_f32_16x16x32_bf16(f.k00, q0, negm, 0, 0, 0); s1 = __builtin_amdgcn_mfma_f32_16x16x32_bf16(f.k10, q0, negm, 0, 0, 0);
    s0 = __builtin_amdgcn_mfma_f32_16x16x32_bf16(f.k01, q1, s0, 0, 0, 0); s1 = __builtin_amdgcn_mfma_f32_16x16x32_bf16(f.k11, q1, s1, 0, 0, 0);
}
constexpr float ATT_THR = 11.5f;
template <bool NB> __device__ __forceinline__ void attn_sv(const VFrag& fv, f32x4 s0, f32x4 s1, const float (&bias)[8], bool force, f32x4& negm, f32x4& lacc, f32x4 (&o)[4]) {
    float s[8];
#pragma unroll
    for (int j = 0; j < 4; ++j) { s[j] = NB ? s0[j] + bias[j] : s0[j]; s[4 + j] = NB ? s1[j] + bias[4 + j] : s1[j]; }
    float mx = s[0];
#pragma unroll
    for (int j = 1; j < 8; ++j) mx = fmaxf(mx, s[j]);
    if (force || __any(mx > ATT_THR)) {
        mx = fmaxf(mx, __shfl_xor(mx, 16)); mx = fmaxf(mx, __shfl_xor(mx, 32));
        const float d = force ? mx : fmaxf(mx, 0.f);
        const float alpha = __builtin_amdgcn_exp2f(fminf(-d, 0.f));
        negm -= d; lacc *= alpha;
        o[0] *= alpha; o[1] *= alpha; o[2] *= alpha; o[3] *= alpha;
#pragma unroll
        for (int j = 0; j < 8; ++j) s[j] -= d;
    }
    float p[8];
#pragma unroll
    for (int j = 0; j < 8; ++j) p[j] = __builtin_amdgcn_exp2f(s[j]);
    u32x4 pw; pw.x = cvt_pk_bf16(p[0], p[1]); pw.y = cvt_pk_bf16(p[2], p[3]); pw.z = cvt_pk_bf16(p[4], p[5]); pw.w = cvt_pk_bf16(p[6], p[7]);
    const bf16x8 pf = __builtin_bit_cast(bf16x8, pw);
    unsigned one2 = 0x3F803F80u; asm volatile("" : "+v"(one2));
    const u32x4 onew = {one2, one2, one2, one2};
    o[0] = __builtin_amdgcn_mfma_f32_16x16x32_bf16(fv.v0, pf, o[0], 0, 0, 0); o[1] = __builtin_amdgcn_mfma_f32_16x16x32_bf16(fv.v1, pf, o[1], 0, 0, 0);
    o[2] = __builtin_amdgcn_mfma_f32_16x16x32_bf16(fv.v2, pf, o[2], 0, 0, 0); o[3] = __builtin_amdgcn_mfma_f32_16x16x32_bf16(fv.v3, pf, o[3], 0, 0, 0);
    lacc = __builtin_amdgcn_mfma_f32_16x16x32_bf16(__builtin_bit_cast(bf16x8, onew), pf, lacc, 0, 0, 0);
}

template <int TYPE>
struct AttnItem {
    static constexpr bool SWA = (TYPE == 0 || TYPE == 2), LAT = (TYPE < 2);
    static constexpr int NQ = LAT ? 2 : 1, NL = LAT ? 9 : 0, NT = NL + 8;
    static constexpr int qc = SWA ? C_AQ : C_BQ, kc = SWA ? C_AK : C_BK, vc = SWA ? C_AV : C_BV, oc = SWA ? 0 : 256;
    const bf16_t* P; const LAS float* rpb; int b, qt, hh, fr, g, kk0, kcolo, vcolo;
    int q0pos;
    int r0, rs0, kc0, nac0, naok;
    __device__ __forceinline__ void offs(int t, unsigned& k0, unsigned& k1, unsigned& v) const {
        const int kk1 = kk0 + 4;
        if (TYPE == 0 && t < NL) {
            const int key0 = q0pos - 128 + 32 * t;
            int p0 = key0 + kk0, p1 = key0 + kk1; p0 = p0 < 0 ? 0 : (p0 > SEQL - 1 ? SEQL - 1 : p0); p1 = p1 < 0 ? 0 : (p1 > SEQL - 1 ? SEQL - 1 : p1);
            int kg = key0 + g * 8; kg = kg < 0 ? 0 : (kg > SEQL - 8 ? SEQL - 8 : kg);
            const int vrow = b * SEQL + kg;
            k0 = (unsigned)(b * SEQL + p0) * PW + kcolo; k1 = (unsigned)(b * SEQL + p1) * PW + kcolo; v = (unsigned)((vrow & ~63) + fr) * PW + vcolo + (vrow & 63);
        } else if (TYPE == 1 && t < NL) {
            int rr = rs0 + t; rr = rr > 31 ? 31 : rr;
            const int rowb = b * SEQL + rr * 64;
            k0 = (unsigned)(rowb + kc0 + kk0) * PW + kcolo; k1 = (unsigned)(rowb + kc0 + kk1) * PW + kcolo; v = (unsigned)(rowb + fr) * PW + vcolo + kc0 + g * 8;
        } else {
            const int ti = t - NL, crow = TLAT + b * CTXL, kg = ti * 32 + g * 8;
            k0 = (unsigned)(crow + ti * 32 + kk0) * PW + kcolo; k1 = (unsigned)(crow + ti * 32 + kk1) * PW + kcolo; v = (unsigned)(crow + (kg & ~63) + fr) * PW + vcolo + (kg & 63);
        }
    }
    __device__ __forceinline__ int bias(float (&bs)[8], int t, int i) const {
        if (TYPE == 0 && t < NL) {
            const int key0 = q0pos - 128 + 32 * t, qb = q0pos + 16 * i, qpos = qb + fr;
            if (key0 + 32 <= 0 || key0 >= SEQL || key0 + 31 < qb - 128 || key0 > qb + 15 + 128) return 0;
            if (key0 >= 0 && key0 + 31 < SEQL && key0 >= qb + 15 - 128 && key0 + 31 <= qb + 128) return 1;
#pragma unroll
            for (int j = 0; j < 8; ++j) { const int kpos = key0 + g * 8 + j; const int d = qpos - kpos; bs[j] = (kpos >= 0 && kpos < SEQL && d <= 128 && d >= -128) ? 0.f : -1e30f; }
            return 2;
        } else if (TYPE == 1 && t < NL) {
            const int r = r0 + i, rr = rs0 + t; int rsi = r - 4; rsi = rsi < 0 ? 0 : (rsi > 24 ? 24 : rsi);
            if (rr < rsi || rr > rsi + 7) return 0;
            const LAS float* bp = rpb + (hh * 465 + (rr - r + 7) * 31 + nac0);
#pragma unroll
            for (int j = 0; j < 8; ++j) bs[j] = ((naok >> j) & 1) ? bp[j] : -1e30f;
            return 2;
        }
        return 1;
    }
    int qrow[2];
    __device__ __forceinline__ void init(int lane) {
        asm volatile("" : "+v"(lane));
        fr = lane & 15; g = lane >> 4; kk0 = (fr >> 2) * 8 + (fr & 3);
        const int kvh = SWA ? (hh >> 1) : hh;
        kcolo = kc + kvh * 64 + g * 8; vcolo = vc + kvh * 64;
        qrow[1] = 0;
        if (TYPE == 0) { q0pos = qt * 32; qrow[0] = b * SEQL + q0pos; qrow[1] = qrow[0] + 16; }
        else if (TYPE == 1) { const int rp = qt >> 2, jb = qt & 3; r0 = 2 * rp; rs0 = r0 - 4; rs0 = rs0 < 0 ? 0 : (rs0 > 24 ? 24 : rs0);
            kc0 = jb == 0 ? 0 : (jb == 1 ? 8 : (jb == 2 ? 24 : 32)); const int qcol = jb * 16 + fr; int wsn = qcol - 8; wsn = wsn < 0 ? 0 : (wsn > 48 ? 48 : wsn);
            nac0 = kc0 + g * 8 - qcol + 15; naok = 0;
#pragma unroll
            for (int j = 0; j < 8; ++j) { const int kcol = kc0 + g * 8 + j; naok |= ((kcol >= wsn) && (kcol < wsn + 16)) ? (1 << j) : 0; }
            qrow[0] = b * SEQL + r0 * 64 + jb * 16; qrow[1] = qrow[0] + 64; }
        else qrow[0] = TLAT + b * CTXL + qt * 16;
    }
    __device__ __forceinline__ void first_loads(bf16x8 (&q0)[2], bf16x8 (&q1)[2], KFrag& kf) const {
#pragma unroll
        for (int i = 0; i < NQ; ++i) { const bf16_t* qp = P + (size_t)(qrow[i] + fr) * PW + qc + hh * 64 + g * 8; q0[i] = *(const bf16x8*)qp; q1[i] = *(const bf16x8*)(qp + 32); }
        unsigned k0_, k1_, v_; offs(0, k0_, k1_, v_); k_load(kf, P, k0_, k1_);
    }
    template <class Next> __device__ __forceinline__ void body(bf16_t* mix, float sinkv, bf16x8 (&q0)[2], bf16x8 (&q1)[2], KFrag& kf, const Next& next) {
        f32x4 negm[NQ], lacc[NQ]; f32x4 o[NQ][4]; bool seen[NQ];
#pragma unroll
        for (int i = 0; i < NQ; ++i) {
            { const float m0 = SWA ? -sinkv * 1.4426950408889634f : 0.f, l0 = SWA ? 1.f : 0.f; negm[i] = (f32x4){m0, m0, m0, m0}; lacc[i] = (f32x4){l0, l0, l0, l0}; seen[i] = SWA; }
#pragma unroll
            for (int dt = 0; dt < 4; ++dt) o[i][dt] = (f32x4){0.f, 0.f, 0.f, 0.f}; }
        VFrag va, vb; unsigned vnext;
        { unsigned k0_, k1_; offs(0, k0_, k1_, vnext); v_load(va, P, vnext); }
#define ATT_SM(VC, t) _Pragma("unroll") for (int i = 0; i < NQ; ++i) { float bs_[8]; const int bc_ = bias(bs_, (t), i); if (bc_ == 2) { attn_sv<true>(VC, sa_[i], sb_[i], bs_, !seen[i], negm[i], lacc[i], o[i]); seen[i] = true; } else if (bc_ == 1) { attn_sv<false>(VC, sa_[i], sb_[i], bs_, !seen[i], negm[i], lacc[i], o[i]); seen[i] = true; } }
#define ATT_STEP(VC, VN, t) do { f32x4 sa_[NQ], sb_[NQ]; _Pragma("unroll") for (int i = 0; i < NQ; ++i) attn_qk(kf, q0[i], q1[i], negm[i], sa_[i], sb_[i]); \
            { unsigned k0_, k1_; offs((t) + 1, k0_, k1_, vnext); k_load(kf, P, k0_, k1_); v_load(VN, P, vnext); } ATT_SM(VC, t) } while (0)
#define ATT_LAST(VC, t) do { f32x4 sa_[NQ], sb_[NQ]; _Pragma("unroll") for (int i = 0; i < NQ; ++i) attn_qk(kf, q0[i], q1[i], negm[i], sa_[i], sb_[i]); \
            next.loads(q0, q1, kf); ATT_SM(VC, t) } while (0)
        int t = 0;
#pragma clang loop unroll(disable)
        for (; t + 2 < NT; t += 2) { ATT_STEP(va, vb, t); ATT_STEP(vb, va, t + 1); }
        if (NT & 1) ATT_LAST(va, NT - 1); else { ATT_STEP(va, vb, NT - 2); ATT_LAST(vb, NT - 1); }
#undef ATT_STEP
#undef ATT_LAST
#undef ATT_SM
#pragma unroll
        for (int i = 0; i < NQ; ++i) {
            const float inv = __builtin_amdgcn_rcpf(lacc[i][0]);
            bf16_t* op = mix + (size_t)(qrow[i] + fr) * DM + oc + hh * 64 + g * 4;
#pragma unroll
            for (int dt = 0; dt < 4; ++dt) { u32x2 w; w.x = cvt_pk_bf16(o[i][dt][0] * inv, o[i][dt][1] * inv); w.y = cvt_pk_bf16(o[i][dt][2] * inv, o[i][dt][3] * inv); *(u32x2*)(op + dt * 16) = w; } }
    }
};

constexpr int ATT_LDS_RPB = 114688, ATT_LDS_CTR = ATT_LDS_RPB + 7680;
__device__ __forceinline__ void attn_setup(Ctx c, int l) {
    { int t_ = TID_NOW(c.wave); asm volatile("" : "+v"(t_)); c.tid = t_; c.lane = t_ & 63; }
    LAS float* rpb = (LAS float*)(c.lds + ATT_LDS_RPB);
    { float rv_[4];
#pragma unroll
      for (int j = 0; j < 4; ++j) { const int i = c.tid + j * NTHR; rv_[j] = c.in[11][(size_t)l * 1860 + (i < 1860 ? i : 0)]; }
#pragma unroll
      for (int j = 0; j < 4; ++j) { const int i = c.tid + j * NTHR; if (i < 1860) rpb[i] = rv_[j] * 1.4426950408889634f; } }
    if (c.tid == 0) *(LAS int*)(c.lds + ATT_LDS_CTR) = 0;
}
struct AttnSel { int perB, nItems, xcd, wq;
    __device__ __forceinline__ void decode(int q, int& type, int& b, int& qt, int& hh) const {
        const int bi = q / perB, r = q % perB; b = xcd + 8 * bi;
        const int it = r < 16 ? (r >> 3) * 256 + wq * 8 + (r & 7) : 512 + wq * 4 + (r - 16);
        if (it < 256) { type = 1; hh = it & 3; qt = it >> 2; }
        else if (it < 512) { const int j = it - 256; type = 0; hh = j & 3; qt = j >> 2; }
        else if (it < 576) { const int j = it - 512; type = 3; hh = j & 3; qt = j >> 2; }
        else { const int j = it - 576; type = 2; hh = j & 3; qt = j >> 2; }
    }
};
template <int TYPE> __device__ __forceinline__ void attn_first(const bf16_t* P, int b, int qt, int hh, int lane, bf16x8 (&q0)[2], bf16x8 (&q1)[2], KFrag& kf) {
    AttnItem<TYPE> B; B.P = P; B.rpb = nullptr; B.b = b; B.qt = qt; B.hh = hh; B.init(lane); B.first_loads(q0, q1, kf);
}
struct AttnNext { AttnSel sel; const bf16_t* P; int q, lane;
    __device__ __forceinline__ void loads(bf16x8 (&q0)[2], bf16x8 (&q1)[2], KFrag& kf) const {
        if (q >= sel.nItems) return;
        int type, b, qt, hh; sel.decode(q, type, b, qt, hh);
        if (type == 1) attn_first<1>(P, b, qt, hh, lane, q0, q1, kf); else if (type == 0) attn_first<0>(P, b, qt, hh, lane, q0, q1, kf);
        else if (type == 3) attn_first<3>(P, b, qt, hh, lane, q0, q1, kf); else attn_first<2>(P, b, qt, hh, lane, q0, q1, kf);
    }
};
__device__ __forceinline__ void phase_attn(Ctx c, int l) {
    { int t_ = TID_NOW(c.wave); asm volatile("" : "+v"(t_)); c.tid = t_; c.lane = t_ & 63; }
    const bf16_t* P = (const bf16_t*)(c.ws + WS_P);
    bf16_t* mix = (bf16_t*)(c.ws + WS_MIX);
    const LAS float* rpb = (const LAS float*)(c.lds + ATT_LDS_RPB);
    LAS int* ctr = (LAS int*)(c.lds + ATT_LDS_CTR);
    const float* sink = c.in[10] + l * 4;
    const float sk0 = sink[0], sk1 = sink[1], sk2 = sink[2], sk3 = sink[3];
    const int lane = c.lane;
    AttnSel sel; sel.xcd = c.wg & 7; sel.wq = c.wg >> 3;
    sel.perB = (l == 0) ? 20 : 16;
    sel.nItems = 4 * sel.perB;
    bf16x8 q0[2], q1[2]; KFrag kf;
    int cur; { int q = 0; if (lane == 0) q = atomicAdd((int*)ctr, 1); cur = __builtin_amdgcn_readfirstlane(q); }
    if (cur >= sel.nItems) return;
    { AttnNext f; f.sel = sel; f.P = P; f.q = cur; f.lane = lane; f.loads(q0, q1, kf); }
#pragma clang loop unroll(disable)
    for (;;) {
        AttnNext nx; nx.sel = sel; nx.P = P; nx.lane = lane;
        { int q = 0; if (lane == 0) q = atomicAdd((int*)ctr, 1); nx.q = __builtin_amdgcn_readfirstlane(q); }
        int type, b, qt, hh; sel.decode(cur, type, b, qt, hh);
        const float sinkv = hh == 0 ? sk0 : (hh == 1 ? sk1 : (hh == 2 ? sk2 : sk3));
        if (type == 1) { AttnItem<1> A; A.P = P; A.rpb = rpb; A.hh = hh; A.qt = qt; A.b = b; A.init(lane); A.body(mix, sinkv, q0, q1, kf, nx); }
        else if (type == 0) { AttnItem<0> A; A.P = P; A.rpb = rpb; A.hh = hh; A.qt = qt; A.b = b; A.init(lane); A.body(mix, sinkv, q0, q1, kf, nx); }
        else if (type == 3) { AttnItem<3> A; A.P = P; A.rpb = rpb; A.hh = hh; A.qt = qt; A.b = b; A.init(lane); A.body(mix, sinkv, q0, q1, kf, nx); }
        else { AttnItem<2> A; A.P = P; A.rpb = rpb; A.hh = hh; A.qt = qt; A.b = b; A.init(lane); A.body(mix, sinkv, q0, q1, kf, nx); }
        if (nx.q >= sel.nItems) break;
        cur = nx.q;
    }
}

__device__ __forceinline__ void phase_mix2(Ctx c, int l, int tmask) {
    { int t_ = TID_NOW(c.wave); asm volatile("" : "+v"(t_)); c.tid = t_; c.lane = t_ & 63; }
    const bf16_t* P = (const bf16_t*)(c.ws + WS_P);
    bf16_t* mix = (bf16_t*)(c.ws + WS_MIX);
    const bf16_t* S = (const bf16_t*)(c.ws + WS_H);
    const int lane = c.lane, fr = lane & 15, g4 = lane >> 4;
    const int gw = c.wg * 8 + c.wave, nw = c.G * 8;
    const int nrows = (l == 0) ? TALL : TLAT;
    const int nGlu = nrows / 16;
    const int n3 = 0, n4 = n3 + nGlu, n5 = n4 + nrows / 4;
    LAS bf16_t* GLW = (LAS bf16_t*)(c.lds + 8192);
    { const bf16_t* GluT = (const bf16_t*)(c.ws + WS_GLUT) + (size_t)l * 65536;
      u32x4 gt_[16];
#pragma unroll
      for (int jj = 0; jj < 16; ++jj) { const int i = c.tid + jj * NTHR, n = i >> 5, k8 = (i & 31) * 8; gt_[jj] = *(const u32x4*)(GluT + n * 256 + k8); }
#pragma unroll
      for (int jj = 0; jj < 16; ++jj) { const int i = c.tid + jj * NTHR, n = i >> 5, k8 = (i & 31) * 8; *(LAS u32x4*)(GLW + n * 264 + k8) = gt_[jj]; } }
    LAS float* DVL = (LAS float*)c.lds; LAS float* GBL = DVL + 256;
    if (c.tid < 256) { DVL[c.tid] = c.in[21][(size_t)l * 256 + c.tid]; GBL[c.tid] = c.in[23][(size_t)l * 256 + c.tid]; }
    __syncthreads();
    const int nExtra = n4 % nw, nwc = nw - nExtra, nGluMine = (n4 - gw + nw - 1) / nw, ncomb = n5 - n4;
    for (int n = 0;; ++n) {
        int it;
        if (n < nGluMine) it = gw + n * nw;
        else { if (gw < nExtra) break; const int j = (gw - nExtra) + (n - nGluMine) * nwc; if (j >= ncomb) break; it = n4 + j; }
        if (false) {}
        else if (it < n4) {
            if (!(tmask & 16)) continue;
            const int row0 = it * 16; const int row = row0 + fr;
            bf16x8 zf[8];
#pragma unroll
            for (int ks = 0; ks < 8; ++ks) { const int k0 = ks * 32 + g4 * 8;
                const u32x4 uu = *(const u32x4*)(P + (size_t)row * PW + C_DU + k0), ya = *(const u32x4*)(S + 2 * SPART + (size_t)row * 256 + k0), yb = *(const u32x4*)(S + 3 * SPART + (size_t)row * 256 + k0);
                const f32x4 d0 = *(const LAS f32x4*)(DVL + k0), d1 = *(const LAS f32x4*)(DVL + k0 + 4);
                float z[8];
                z[0] = gelu_tanh(d0[0] * lo_bf(uu.x) + lo_bf(ya.x) + lo_bf(yb.x)); z[1] = gelu_tanh(d0[1] * hi_bf(uu.x) + hi_bf(ya.x) + hi_bf(yb.x));
                z[2] = gelu_tanh(d0[2] * lo_bf(uu.y) + lo_bf(ya.y) + lo_bf(yb.y)); z[3] = gelu_tanh(d0[3] * hi_bf(uu.y) + hi_bf(ya.y) + hi_bf(yb.y));
                z[4] = gelu_tanh(d1[0] * lo_bf(uu.z) + lo_bf(ya.z) + lo_bf(yb.z)); z[5] = gelu_tanh(d1[1] * hi_bf(uu.z) + hi_bf(ya.z) + hi_bf(yb.z));
                z[6] = gelu_tanh(d1[2] * lo_bf(uu.w) + lo_bf(ya.w) + lo_bf(yb.w)); z[7] = gelu_tanh(d1[3] * hi_bf(uu.w) + hi_bf(ya.w) + hi_bf(yb.w));
                u32x4 w; w.x = cvt_pk_bf16(z[0], z[1]); w.y = cvt_pk_bf16(z[2], z[3]); w.z = cvt_pk_bf16(z[4], z[5]); w.w = cvt_pk_bf16(z[6], z[7]);
                zf[ks] = __builtin_bit_cast(bf16x8, w); }
#pragma unroll
            for (int ntl = 0; ntl < 16; ++ntl) {
                f32x4 a = (f32x4){0.f, 0.f, 0.f, 0.f};
#pragma unroll
                for (int ks = 0; ks < 8; ++ks) { const bf16x8 wf = *(const LAS bf16x8*)(GLW + (ntl * 16 + fr) * 264 + ks * 32 + g4 * 8); a = __builtin_amdgcn_mfma_f32_16x16x32_bf16(wf, zf[ks], a, 0, 0, 0); }
                const int n0c = ntl * 16 + g4 * 4;
                const u32x4 zw = __builtin_bit_cast(u32x4, zf[ntl >> 1]);
                const int src = fr + 16 * ((ntl & 1) * 2 + (g4 >> 1));
                const unsigned w0 = __shfl(zw.x, src), w1 = __shfl(zw.y, src), w2 = __shfl(zw.z, src), w3 = __shfl(zw.w, src);
                const unsigned zlo = (g4 & 1) ? w2 : w0, zhi = (g4 & 1) ? w3 : w1;
                const f32x4 b0 = *(const LAS f32x4*)(GBL + n0c);
                const float z0 = lo_bf(zlo), z1 = hi_bf(zlo), z2 = lo_bf(zhi), z3 = hi_bf(zhi);
                u32x2 w; w.x = cvt_pk_bf16(z0 * sigmoidf_(a[0] + b0[0]), z1 * sigmoidf_(a[1] + b0[1])); w.y = cvt_pk_bf16(z2 * sigmoidf_(a[2] + b0[2]), z3 * sigmoidf_(a[3] + b0[3]));
                *(u32x2*)(mix + (size_t)row * DM + 768 + n0c) = w;
            }
        } else {
            if (!(tmask & 32)) continue;
            const int rowq = (it - n4) * 4; const int ch = lane * 4;
            u32x2 a[4], bq[4], gg[4];
#pragma unroll
            for (int q = 0; q < 4; ++q) { const int row = rowq + q; a[q] = *(const u32x2*)(S + (size_t)row * 256 + ch); bq[q] = *(const u32x2*)(S + SPART + (size_t)row * 256 + ch); gg[q] = *(const u32x2*)(P + (size_t)row * PW + C_CG + ch); }
            const f32x4 nwv = *(const f32x4*)(c.in[13] + (size_t)l * 64 + (ch & 63));
#pragma unroll
            for (int q = 0; q < 4; ++q) { const int row = rowq + q;
                float ov[4] = {lo_bf(a[q].x) + lo_bf(bq[q].x), hi_bf(a[q].x) + hi_bf(bq[q].x), lo_bf(a[q].y) + lo_bf(bq[q].y), hi_bf(a[q].y) + hi_bf(bq[q].y)};
                float ss = ov[0] * ov[0] + ov[1] * ov[1] + ov[2] * ov[2] + ov[3] * ov[3];
                ss += __shfl_xor(ss, 1); ss += __shfl_xor(ss, 2); ss += __shfl_xor(ss, 4); ss += __shfl_xor(ss, 8);
                const float rs = rsqrtf(ss * (1.0f / 64.0f) + NORM_EPS);
                const float gv[4] = {lo_bf(gg[q].x), hi_bf(gg[q].x), lo_bf(gg[q].y), hi_bf(gg[q].y)};
                float r4[4];
#pragma unroll
                for (int j = 0; j < 4; ++j) r4[j] = ov[j] * rs * nwv[j] * siluf_(gv[j]);
                u32x2 w; w.x = cvt_pk_bf16(r4[0], r4[1]); w.y = cvt_pk_bf16(r4[2], r4[3]);
                *(u32x2*)(mix + (size_t)row * DM + 512 + ch) = w; }
        }
    }
}

__device__ __forceinline__ void phase_convert(Ctx c, int l) {
    { int t_ = TID_NOW(c.wave); asm volatile("" : "+v"(t_)); c.tid = t_; c.lane = t_ & 63; }
    bf16_t* W1T = (bf16_t*)(c.ws + WS_W1T); bf16_t* W2T = (bf16_t*)(c.ws + WS_W2T);
    for (int it = c.wg * 8 + c.wave; it < NEXP * 384; it += c.G * 8) {
        const int e = it / 384, r = it % 384;
        if (r < 256) { const int u = r >> 7, rr = r & 127, kt = rr >> 3, ntl = rr & 7;
            const float* src = c.in[u ? 29 : 28] + ((size_t)l * NEXP + e) * DM * MHID + (size_t)kt * 64 * MHID + ntl * 64;
            const int col = ntl * 64, drow = (col >> 7) * 256 + u * 128 + (col & 127);
            transpose_tile(c, src, MHID, W1T + (size_t)e * 1024 * 1024 + (size_t)drow * 1024 + kt * 64, 1024); }
        else { const int rr = r - 256, kt = rr >> 4, ntl = rr & 15;
            const float* src = c.in[30] + ((size_t)l * NEXP + e) * MHID * DM + (size_t)kt * 64 * DM + ntl * 64;
            transpose_tile(c, src, DM, W2T + (size_t)e * 1024 * MHID + (size_t)ntl * 64 * MHID + kt * 64, MHID); }
    }
}

__device__ __forceinline__ void phase_norm2(Ctx c, int l) {
    { int t_ = TID_NOW(c.wave); asm volatile("" : "+v"(t_)); c.tid = t_; c.lane = t_ & 63; }
    constexpr int WSR = 1032;
    LAS bf16_t* WH = (LAS bf16_t*)c.lds; LAS bf16_t* WL = WH + 36 * WSR;
    LAS int* hist = (LAS int*)(c.lds + 2 * 36 * WSR * 2);
    { f32x4 wr_[18];
#pragma unroll
      for (int jj = 0; jj < 18; ++jj) { const int i = c.tid + jj * NTHR;
          if (i < 1024) wr_[jj] = *(const f32x4*)(c.in[24] + ((size_t)l * DM + i) * 4);
          else { const int j = i - 1024; wr_[jj] = *(const f32x4*)(c.in[26] + ((size_t)l * DM + (j >> 3)) * 32 + (j & 7) * 4); } }
#pragma unroll
      for (int jj = 0; jj < 18; ++jj) { const int i = c.tid + jj * NTHR; int d, n0;
          if (i < 1024) { d = i; n0 = 0; } else { const int j = i - 1024; d = j >> 3; n0 = 4 + (j & 7) * 4; }
#pragma unroll
          for (int q = 0; q < 4; ++q) { const bf16_t hi = f2bf(wr_[jj][q]); WH[(n0 + q) * WSR + d] = hi; WL[(n0 + q) * WSR + d] = f2bf(wr_[jj][q] - bf2f(hi)); } } }
    LAS float* NWL = (LAS float*)(c.lds + 148992);
    for (int i = c.tid; i < DM / 4; i += NTHR) ((LAS f32x4*)NWL)[i] = ((const f32x4*)(c.in[7] + (size_t)l * DM))[i];
    if (c.tid < 64) hist[c.tid] = 0;
    LAS int* tctr = hist + 64;
    if (c.tid == 64) *tctr = 0;
    __syncthreads();
    const int T = (l == 0) ? TALL : TLAT, RPW = T / NWG;
    const float* modv = (const float*)(c.ws + WS_MODV) + (size_t)l * 33 * 6144;
    const float* nw = c.in[7] + (size_t)l * DM;
    const bf16_t* X = (const bf16_t*)(c.ws + WS_X);
    bf16_t* H = (bf16_t*)(c.ws + WS_H);
    int* tokE = (int*)(c.ws + WS_TOKE); float* tokW = (float*)(c.ws + WS_TOKW);
    const int lane = c.lane, fr = lane & 15, g4 = lane >> 4;
    const float bz0 = fr < 4 ? c.in[25][l * 4 + fr] : c.in[27][l * 32 + fr - 4], bz1 = c.in[27][l * 32 + 12 + fr], bz2 = fr < 4 ? c.in[27][l * 32 + 28 + fr] : 0.f;
    const int nr1 = 16 + fr, nr2 = fr < 4 ? 32 + fr : 35;
    auto tile_body = [&](auto MTC, const int row0) __attribute__((always_inline)) {
        constexpr int MT = decltype(MTC)::value;
        const bf16_t* xr[MT]; float rstd[MT];
#pragma unroll
        for (int mt = 0; mt < MT; ++mt) { const int row = row0 + 16 * mt + fr;
            xr[mt] = X + (size_t)row * DM + g4 * 8;
            float ss; { const f32x4 pv = *(const f32x4*)((const float*)(c.ws + WS_SSQ) + (size_t)row * 16 + g4 * 4); ss = (pv[0] + pv[1]) + (pv[2] + pv[3]); }
            ss += __shfl_xor(ss, 16); ss += __shfl_xor(ss, 32);
            rstd[mt] = rsqrtf(ss * (1.0f / DM) + NORM_EPS); }
        const float* mp = modv + (size_t)mod_row(row0) * 6144 + g4 * 8;
        const LAS float* nwp = NWL + g4 * 8;
        f32x4 acc[MT][3];
#pragma unroll
        for (int mt = 0; mt < MT; ++mt) { acc[mt][0] = (f32x4){0.f, 0.f, 0.f, 0.f}; acc[mt][1] = acc[mt][0]; acc[mt][2] = acc[mt][0]; }
        u32x4 XR[MT][8]; f32x4 L[2][6];
#define N2_LOADX(j, k0) do { _Pragma("unroll") for (int mt = 0; mt < MT; ++mt) XR[mt][j] = *(const u32x4*)(xr[mt] + (k0)); } while (0)
#define N2_LOADC(buf, k0) do { L[buf][0] = *(const LAS f32x4*)(nwp + (k0)); L[buf][1] = *(const LAS f32x4*)(nwp + (k0) + 4); \
            L[buf][2] = *(const f32x4*)(mp + 3 * 1024 + (k0)); L[buf][3] = *(const f32x4*)(mp + 3 * 1024 + (k0) + 4); L[buf][4] = *(const f32x4*)(mp + 4 * 1024 + (k0)); L[buf][5] = *(const f32x4*)(mp + 4 * 1024 + (k0) + 4); } while (0)
#define N2_STEP(j, buf, k0) do { \
            const f32x4 ca_ = L[buf][0] * (L[buf][4] + 1.0f), cb_ = L[buf][1] * (L[buf][5] + 1.0f); \
            bf16x8 ah[MT], al[MT]; \
            _Pragma("unroll") for (int mt = 0; mt < MT; ++mt) { const u32x4 xq = XR[mt][j]; \
            const f32x4 x0_ = (f32x4){lo_bf(xq.x), hi_bf(xq.x), lo_bf(xq.y), hi_bf(xq.y)}, x1_ = (f32x4){lo_bf(xq.z), hi_bf(xq.z), lo_bf(xq.w), hi_bf(xq.w)}; \
            const f32x4 xa = (x0_ * rstd[mt]) * ca_ + L[buf][2], xb = (x1_ * rstd[mt]) * cb_ + L[buf][3]; \
            u32x4 hi; hi.x = cvt_pk_bf16(xa[0], xa[1]); hi.y = cvt_pk_bf16(xa[2], xa[3]); hi.z = cvt_pk_bf16(xb[0], xb[1]); hi.w = cvt_pk_bf16(xb[2], xb[3]); \
            *(u32x4*)(H + (size_t)(row0 + 16 * mt + fr) * DM + g4 * 8 + (k0)) = hi; \
            u32x4 lo; lo.x = cvt_pk_bf16(xa[0] - lo_bf(hi.x), xa[1] - hi_bf(hi.x)); lo.y = cvt_pk_bf16(xa[2] - lo_bf(hi.y), xa[3] - hi_bf(hi.y)); \
            lo.z = cvt_pk_bf16(xb[0] - lo_bf(hi.z), xb[1] - hi_bf(hi.z)); lo.w = cvt_pk_bf16(xb[2] - lo_bf(hi.w), xb[3] - hi_bf(hi.w)); \
            ah[mt] = __builtin_bit_cast(bf16x8, hi); al[mt] = __builtin_bit_cast(bf16x8, lo); } \
            _Pragma("unroll") for (int nt = 0; nt < 3; ++nt) { const int nrow = nt == 0 ? fr : (nt == 1 ? nr1 : nr2); \
            const bf16x8 bh = *(const LAS bf16x8*)(WH + nrow * WSR + g4 * 8 + (k0)), bl = *(const LAS bf16x8*)(WL + nrow * WSR + g4 * 8 + (k0)); \
            _Pragma("unroll") for (int mt = 0; mt < MT; ++mt) { \
            acc[mt][nt] = __builtin_amdgcn_mfma_f32_16x16x32_bf16(ah[mt], bh, acc[mt][nt], 0, 0, 0); acc[mt][nt] = __builtin_amdgcn_mfma_f32_16x16x32_bf16(ah[mt], bl, acc[mt][nt], 0, 0, 0); acc[mt][nt] = __builtin_amdgcn_mfma_f32_16x16x32_bf16(al[mt], bh, acc[mt][nt], 0, 0, 0); } } } while (0)
#pragma unroll
        for (int j = 0; j < 8; ++j) N2_LOADX(j, j * 32);
        N2_LOADC(0, 0); N2_LOADC(1, 32);
#pragma clang loop unroll(disable)
        for (int kb = 0; kb < 32; kb += 8) {
#pragma unroll
            for (int j = 0; j < 8; ++j) { const int ks = kb + j;
                N2_STEP(j, (j & 1), ks * 32);
                if (ks + 8 < 32) N2_LOADX(j, (ks + 8) * 32);
                if (ks + 2 < 32) N2_LOADC((j & 1), (ks + 2) * 32); }
        }
#undef N2_LOADX
#undef N2_LOADC
#undef N2_STEP
#pragma unroll
        for (int mt = 0; mt < MT; ++mt)
#pragma unroll
        for (int r = 0; r < 4; ++r) {
            const float v0 = acc[mt][0][r] + bz0, v1 = acc[mt][1][r] + bz1, v2 = acc[mt][2][r] + bz2;
            const int gb = lane & 48;
            const float g0 = __shfl(v0, gb + 0), g1 = __shfl(v0, gb + 1), g2 = __shfl(v0, gb + 2), g3 = __shfl(v0, gb + 3);
            int gi = 0; float gm = g0; if (g1 > gm) { gm = g1; gi = 1; } if (g2 > gm) { gm = g2; gi = 2; } if (g3 > gm) { gm = g3; gi = 3; }
            const float gwt = __builtin_amdgcn_rcpf(__expf(g0 - gm) + __expf(g1 - gm) + __expf(g2 - gm) + __expf(g3 - gm));
            float ev[8];
#pragma unroll
            for (int j = 0; j < 8; ++j) { const int n = 4 + 8 * gi + j, tj = n >> 4; const float send = tj == 0 ? v0 : (tj == 1 ? v1 : v2); ev[j] = __shfl(send, gb + (n & 15)); }
            int i1 = 0; float e1 = ev[0];
#pragma unroll
            for (int j = 1; j < 8; ++j) if (ev[j] > e1) { e1 = ev[j]; i1 = j; }
            int i2 = -1; float e2v = -3.0e38f;
#pragma unroll
            for (int j = 0; j < 8; ++j) if (j != i1 && ev[j] > e2v) { e2v = ev[j]; i2 = j; }
            const float ex = __expf(e2v - e1), w1 = gwt * __builtin_amdgcn_rcpf(1.0f + ex), w2 = w1 * ex;
            if (fr == 0) { const int rr = row0 + 16 * mt + g4 * 4 + r, ea = gi * 8 + i1, eb = gi * 8 + i2; tokE[rr] = ea; tokE[TALL + rr] = eb; tokW[rr] = w1; tokW[TALL + rr] = w2;
                atomicAdd((int*)&hist[ea], 1); atomicAdd((int*)&hist[32 + eb], 1); }
        }
    };
    const int nsmall = (RPW - 256) / 16;
    for (;;) {
        int tile = 0; if (lane == 0) tile = atomicAdd((int*)tctr, 1);
        tile = __builtin_amdgcn_readfirstlane(tile);
        if (tile >= 8 + nsmall) break;
        if (tile < 8) tile_body(std::integral_constant<int, 2>{}, c.wg * RPW + tile * 32);
        else tile_body(std::integral_constant<int, 1>{}, c.wg * RPW + 256 + (tile - 8) * 16);
    }
    __syncthreads();
    if (c.tid < 64) ((int*)(c.ws + WS_HIST))[c.wg * 64 + c.tid] = hist[c.tid];
}

__device__ __forceinline__ void phase_sort(Ctx c, int l) {
    { int t_ = TID_NOW(c.wave); asm volatile("" : "+v"(t_)); c.tid = t_; c.lane = t_ & 63; }
    const int T = (l == 0) ? TALL : TLAT, RPW = T / NWG;
    LAS int* tot = (LAS int*)c.lds; LAS int* pre = tot + 64; LAS int* seg = pre + 64; LAS int* myE = seg + 64;
    const int* hist = (const int*)(c.ws + WS_HIST);
    const int* tokE = (const int*)(c.ws + WS_TOKE); const float* tokW = (const float*)(c.ws + WS_TOKW);
    int* slotTok = (int*)(c.ws + WS_SLOTTOK); float* slotW = (float*)(c.ws + WS_SLOTW);
    if (c.tid < 128) tot[c.tid] = 0;
    __syncthreads();
    { const int bin = c.tid & 63, part = c.tid >> 6; int t = 0, p = 0;
      int hv_[32];
#pragma unroll
      for (int j = 0; j < 32; ++j) hv_[j] = hist[(part * 32 + j) * 64 + bin];
#pragma unroll
      for (int j = 0; j < 32; ++j) { t += hv_[j]; if (part * 32 + j < c.wg) p += hv_[j]; }
      atomicAdd((int*)&tot[bin], t); atomicAdd((int*)&pre[bin], p); }
    { int ev_[2];
#pragma unroll
      for (int j = 0; j < 2; ++j) { const int i = c.tid + j * NTHR, ii = i < 2 * RPW ? i : 0, k = ii / RPW, r = ii % RPW; ev_[j] = tokE[k * TALL + c.wg * RPW + r]; }
#pragma unroll
      for (int j = 0; j < 2; ++j) { const int i = c.tid + j * NTHR; if (i < 2 * RPW) myE[i] = ev_[j]; } }
    __syncthreads();
    if (c.tid < 2) { int run = 0; for (int e = 0; e < 32; ++e) { seg[c.tid * 32 + e] = run; run += (tot[c.tid * 32 + e] + 255) & ~255; }
        if (c.wg == 0) ((int*)(c.ws + WS_NTILES))[c.tid] = run >> 8; }
    __syncthreads();
    { float wv_[2];
#pragma unroll
      for (int j = 0; j < 2; ++j) { const int i = c.tid + j * NTHR, ii = i < 2 * RPW ? i : 0, k = ii / RPW, r = ii % RPW; wv_[j] = tokW[k * TALL + c.wg * RPW + r]; }
#pragma unroll
      for (int j = 0; j < 2; ++j) { const int i = c.tid + j * NTHR;
        if (i < 2 * RPW) { const int k = i / RPW, r = i % RPW, e = myE[i]; int rank = 0;
            for (int q = 0; q < r; ++q) rank += (myE[k * RPW + q] == e) ? 1 : 0;
            const int pos = seg[k * 32 + e] + pre[k * 32 + e] + rank; const int row = c.wg * RPW + r;
            slotTok[k * SLOTCAP + pos] = row; slotW[k * SLOTCAP + pos] = wv_[j]; } } }
    if (c.wg < 64) { const int bin = c.wg, k = bin >> 5; const int s0 = seg[bin] + tot[bin], s1 = seg[bin] + ((tot[bin] + 255) & ~255);
        for (int p = s0 + c.tid; p < s1; p += NTHR) { slotTok[k * SLOTCAP + p] = -1; slotW[k * SLOTCAP + p] = 0.f; }
        int* tileE = (int*)(c.ws + WS_TILEE) + k * 512;
        for (int t = (seg[bin] >> 8) + c.tid; t < (s1 >> 8); t += NTHR) tileE[t] = bin & 31; }
}

__device__ __forceinline__ void phase_final(Ctx c) {
    { int t_ = TID_NOW(c.wave); asm volatile("" : "+v"(t_)); c.tid = t_; c.lane = t_ & 63; }
    constexpr int NR = 4;
    const bf16_t* X = (const bf16_t*)(c.ws + WS_X); const float* nw = c.in[31];
    const float* modp = (const float*)(c.ws + WS_MODV) + (size_t)33 * 6144 + 5 * 1024;
    const bf16_t* Y = (const bf16_t*)(c.ws + WS_MIX); const bf16_t* Y1 = (const bf16_t*)(c.ws + WS_H);
    const int nw8 = c.G * 8;
    f32x4 wv[4];
#pragma unroll
    for (int k = 0; k < 4; ++k) wv[k] = *(const f32x4*)(nw + (k >> 1) * 512 + c.lane * 8 + (k & 1) * 4);
    for (int row0 = (c.wg * 8 + c.wave) * NR; row0 < TLAT; row0 += NR * nw8) {
        u32x4 xa[NR][2], ya[NR][2], za[NR][2];
#pragma unroll
        for (int q = 0; q < NR; ++q)
#pragma unroll
            for (int j = 0; j < 2; ++j) { const size_t o = (size_t)(row0 + q) * DM + j * 512 + c.lane * 8; xa[q][j] = *(const u32x4*)(X + o); ya[q][j] = *(const u32x4*)(Y + o); za[q][j] = *(const u32x4*)(Y1 + o); }
        const float* ga = modp + (size_t)mod_row(row0) * 6144;
        f32x4 gt[4];
#pragma unroll
        for (int k = 0; k < 4; ++k) gt[k] = *(const f32x4*)(ga + (k >> 1) * 512 + c.lane * 8 + (k & 1) * 4);
#pragma unroll
        for (int q = 0; q < NR; ++q) { const int row = row0 + q;
            f32x4 v[2][2]; float ss = 0.f;
#pragma unroll
            for (int j = 0; j < 2; ++j) { const u32x4 xx = xa[q][j], yy = ya[q][j], zz = za[q][j];
                v[j][0] = (f32x4){lo_bf(xx.x), hi_bf(xx.x), lo_bf(xx.y), hi_bf(xx.y)} + gt[2 * j] * ((f32x4){lo_bf(yy.x), hi_bf(yy.x), lo_bf(yy.y), hi_bf(yy.y)} + (f32x4){lo_bf(zz.x), hi_bf(zz.x), lo_bf(zz.y), hi_bf(zz.y)});
                v[j][1] = (f32x4){lo_bf(xx.z), hi_bf(xx.z), lo_bf(xx.w), hi_bf(xx.w)} + gt[2 * j + 1] * ((f32x4){lo_bf(yy.z), hi_bf(yy.z), lo_bf(yy.w), hi_bf(yy.w)} + (f32x4){lo_bf(zz.z), hi_bf(zz.z), lo_bf(zz.w), hi_bf(zz.w)});
#pragma unroll
                for (int h = 0; h < 2; ++h) ss += (v[j][h][0] * v[j][h][0] + v[j][h][1] * v[j][h][1]) + (v[j][h][2] * v[j][h][2] + v[j][h][3] * v[j][h][3]); }
            ss = wave_sum(ss);
            const float rs = rsqrtf(ss * (1.0f / DM) + NORM_EPS);
#pragma unroll
            for (int j = 0; j < 2; ++j) { const int cc = j * 512 + c.lane * 8;
                *(f32x4*)(c.out + (size_t)row * DM + cc) = v[j][0] * rs * wv[2 * j];
                *(f32x4*)(c.out + (size_t)row * DM + cc + 4) = v[j][1] * rs * wv[2 * j + 1]; } }
    }
}

#ifndef MIX_DUP_TYPES
#define MIX_DUP_TYPES 63
#endif
#ifndef DUP_MASK
#define DUP_MASK 0
#endif
constexpr int NPL = 9, NPH = 1 + 2 * NPL + 1;
#ifndef PHASE_MASK
#define PHASE_MASK 0xFFFF
#endif
#define HAS(k) (((PHASE_MASK) >> (k)) & 1)
__global__ void __launch_bounds__(NTHR, 2) fwd_kernel(Args args) {
    extern __shared__ __attribute__((aligned(16))) unsigned char lds_raw[];
    Ctx c; c.in = args.in; c.out = args.out; c.ws = args.ws; c.lds = (LAS unsigned char*)lds_raw;
    c.tid = threadIdx.x; c.lane = c.tid & 63; c.wave = __builtin_amdgcn_readfirstlane(c.tid >> 6); c.G = gridDim.x; c.wg = blockIdx.x;
    const int lo = args.ph_lo, hi = args.ph_hi;
    constexpr int dupm = (DUP_MASK), mixt = (MIX_DUP_TYPES);
    volatile LAS unsigned* bst = (volatile LAS unsigned*)(c.lds + LDS_BYTES - 16);
    XcdBarrier bar; bar.bar = (unsigned*)(c.ws + WS_BAR); bar.x = 0; bar.st = bst; bar.wave = c.wave;
    if (hi - lo > 1) { if (c.tid == 0) { bst[0] = 0u; bst[1] = 0u; } __syncthreads(); bar = xcd_barrier_post((unsigned*)(c.ws + WS_BAR), bst); bar.wave = c.wave; }
#define IN(k) (lo <= (k) && (k) < hi)
#define SEAM(k) do { if (IN(k) && IN((k) + 1)) xcd_barrier(bar); } while (0)
#define RUN(T, k, ...) do { if (HAS(T) && IN(k)) { _Pragma("clang loop unroll(disable)") for (int rep_ = 0; rep_ < 1 + ((dupm >> (T)) & 1); ++rep_) { if (rep_) xcd_barrier(bar); __VA_ARGS__; } } SEAM(k); } while (0)
    RUN(0, 0, phase_prologue(c));
    for (int l = 0; l < 2; ++l) {
        const int pb = 1 + l * NPL;
        const float* modv = (const float*)(c.ws + WS_MODV) + (size_t)l * 33 * 6144;
        RUN(1, pb + 0, { if (l == 0) phase_norm1_l0(c, l); else phase_norm1_l1(c, l); });
        RUN(2, pb + 1, {
            pg8::Gemm g{(const bf16_t*)(c.ws + WS_H), (const bf16_t*)(c.ws + WS_WINT) + (size_t)l * PW * DM, TALL, PW, DM, nullptr};
            pg8::StaticOrder S;
            if (l == 0) S.init(TALL, PW, c.G, c.wg);
            else { S.init(TLAT, PW, c.G, c.wg); S.tail_rows = TCTX / 256; S.tail_ncols = 7; S.tail_map = 0xA876431ull; }
            LAS f32x2* CS = (LAS f32x2*)(c.lds + pg8::STAGE_BYTES);
            { int t_ = TID_NOW(c.wave); asm volatile("" : "+v"(t_));
              for (int e = t_; e < 64 * 16; e += NTHR) { const int pos = e >> 4, i = e & 15; const float inv = __expf(-(float)i * (9.210340371976184f / 16.0f)); float sn, cs; sincosf((float)pos * inv, &sn, &cs); CS[e] = (f32x2){cs, sn}; } }
            __syncthreads();
            pg8::EpiP E{(bf16_t*)(c.ws + WS_P), PW, CS};
            pg8::gemm_phase<pg8::EpiP, pg8::StaticOrder, false>(c.lds, g, S, E, c.wave); });
        RUN(3, pb + 2, { for (int r2 = 0; r2 < 1 + ((dupm >> 12) & 1); ++r2) { phase_hgrn(c, l); __syncthreads(); } attn_setup(c, l); __syncthreads();
            for (int r2 = 0; r2 < 1 + ((dupm >> 13) & 1); ++r2) { if (c.wave < 4) phase_s5(c, l); } phase_attn(c, l); });
        RUN(4, pb + 3, phase_mix2(c, l, rep_ ? mixt : 63));
        RUN(5, pb + 4, {
            const int M = (l == 0) ? TALL : TLAT;
            pg8::Gemm g{(const bf16_t*)(c.ws + WS_MIX), (const bf16_t*)(c.ws + WS_WOUTT) + (size_t)l * DM * DM, M, DM, DM, nullptr};
            pg8::StaticOrder S; S.init(M, DM, c.G, c.wg);
            const bool first = (rep_ == 0);
            pg8::EpiRes E{(bf16_t*)(c.ws + WS_X), modv + 2 * 1024, (float*)(c.ws + WS_SSQ), first ? 1.0f : 0.0f};
            pg8::gemm_phase<pg8::EpiRes, pg8::StaticOrder, false>(c.lds, g, S, E, c.wave); });
        RUN(6, pb + 5, { _Pragma("clang loop unroll(disable)") for (int r2 = 0; r2 < 1 + ((dupm >> 14) & 1); ++r2) { phase_convert(c, l); __syncthreads(); } phase_norm2(c, l); });
        RUN(7, pb + 6, phase_sort(c, l));
        {
            const int vcu = (c.wg & 7) * (c.G >> 3) + (c.wg >> 3);
            const LAS int* mtab = (const LAS int*)(c.lds + pg8::MOE_TAB_OFF); const LAS int* mtok = mtab + 2 * pg8::MOE_MAXU; const LAS float* mw = (const LAS float*)(mtok + pg8::MOE_MAXU * 256);
            RUN(8, pb + 7, {
                const int nt0 = ((const int*)(c.ws + WS_NTILES))[0], nt1 = ((const int*)(c.ws + WS_NTILES))[1];
                pg8::moe_tab_fill(c.lds, (const int*)(c.ws + WS_TILEE), nt0, nt1, (const int*)(c.ws + WS_SLOTTOK), (const float*)(c.ws + WS_SLOTW), SLOTCAP, c.G, vcu, c.wave); __syncthreads();
                pg8::Gemm g{(const bf16_t*)(c.ws + WS_H), (const bf16_t*)(c.ws + WS_W1T), 0, 0, DM, mtok};
                pg8::MoeOrder S{mtab, nt0 + nt1, c.G, vcu};
                pg8::EpiHid E{(bf16_t*)(c.ws + WS_HID)};
                pg8::gemm_phase<pg8::EpiHid, pg8::MoeOrder, true>(c.lds, g, S, E, c.wave); });
            RUN(9, pb + 8, {
                const int nt0 = ((const int*)(c.ws + WS_NTILES))[0], nt1 = ((const int*)(c.ws + WS_NTILES))[1];
                pg8::moe_tab_fill(c.lds, (const int*)(c.ws + WS_TILEE), nt0, nt1, (const int*)(c.ws + WS_SLOTTOK), (const float*)(c.ws + WS_SLOTW), SLOTCAP, c.G, vcu, c.wave); __syncthreads();
                pg8::Gemm g{(const bf16_t*)(c.ws + WS_HID), (const bf16_t*)(c.ws + WS_W2T), 0, 0, MHID, nullptr};
                pg8::MoeOrder S{mtab, nt0 + nt1, c.G, vcu};
                pg8::EpiMoe2 E{(bf16_t*)(c.ws + WS_MIX), (bf16_t*)(c.ws + WS_H), mtok, mw, rep_};
                pg8::gemm_phase<pg8::EpiMoe2, pg8::MoeOrder, false>(c.lds, g, S, E, c.wave); });
        }
    }
    RUN(10, NPH - 1, phase_final(c));
#undef IN
#undef SEAM
#undef RUN
}

extern "C" void kernel_launch(void* const* d_in, const int* in_sizes, int n_in, void* d_out, int out_size, void* d_ws, size_t ws_size, hipStream_t stream) {
    static int grid = 0;
    if (grid == 0) {
        if (n_in != 32 || out_size != TLAT * DM || ws_size < WS_END) { fprintf(stderr, "kernel_launch: unexpected shapes (n_in %d out %d ws %zu)\n", n_in, out_size, ws_size); grid = -1; return; }
        int dev = 0, cus = 0, per_cu = 0;
        hipGetDevice(&dev); hipDeviceGetAttribute(&cus, hipDeviceAttributeMultiprocessorCount, dev);
        if (hipFuncSetAttribute((const void*)fwd_kernel, hipFuncAttributeMaxDynamicSharedMemorySize, LDS_BYTES) != hipSuccess) { fprintf(stderr, "kernel_launch: hipFuncSetAttribute failed\n"); grid = -1; return; }
        hipOccupancyMaxActiveBlocksPerMultiprocessor(&per_cu, (const void*)fwd_kernel, NTHR, LDS_BYTES);
        (void)hipGetLastError();
        if (cus != NWG || per_cu < 1) { fprintf(stderr, "kernel_launch: needs 256 CUs with one resident workgroup each (cus %d, per_cu %d)\n", cus, per_cu); grid = -1; return; }
        grid = NWG;
    }
    if (grid < 0) return;
    hipMemsetAsync((char*)d_ws + WS_BAR, 0, XCD_BAR_WORDS * sizeof(unsigned), stream);
    Args a{};
    for (int i = 0; i < 32; ++i) a.in[i] = (const float*)d_in[i];
    a.out = (float*)d_out; a.ws = (unsigned char*)d_ws; a.dup_mask = (DUP_MASK); a.mix_types = (MIX_DUP_TYPES);
#if N_LAUNCH_MODE == 1
    a.ph_lo = 0; a.ph_hi = NPH;
    hipLaunchKernelGGL(fwd_kernel, dim3(grid), dim3(NTHR), LDS_BYTES, stream, a);
#else
    for (int ph = 0; ph < NPH; ++ph) { a.ph_lo = ph; a.ph_hi = ph + 1; hipLaunchKernelGGL(fwd_kernel, dim3(grid), dim3(NTHR), LDS_BYTES, stream, a); }
#endif
}
```
